# Optimizing an MI355X kernel written in HIP

```python
import math
import jax
import jax.numpy as jnp
from jax import lax
import numpy as np

D_MODEL = 2048
BATCH = 1
SEQ = 16384
DEPTH = 1

CHUNK = 64
Q_BLOCK = 128
MEM_LEN = 256
EPS = 1e-6
MIX_WIDTH = D_MODEL
ATTN_WIDTH = MIX_WIDTH // 2
DA_HEAD_DIM = 64
DA_HEADS = ATTN_WIDTH // (2 * DA_HEAD_DIM)
RNN_WIDTH = MIX_WIDTH - ATTN_WIDTH
RNN_BLOCKS = 8
RNN_BLOCK = RNN_WIDTH // RNN_BLOCKS
CONV_WIDTH = 4
RG_C = 8.0
X_HEADS = 4
X_HEAD_DIM = 128
X_WIDTH = X_HEADS * X_HEAD_DIM
D_FF = -(-8 * D_MODEL // (3 * 256)) * 256
IN_WIDTH = 3 * ATTN_WIDTH + 2 * RNN_WIDTH
NUM_BUCKETS = 32
MAX_DISTANCE = 1024

kernel_name = 'hybrid_diffattn_rglru_memxattn_layer'


def lambda_init(layer):
    return 0.8 - 0.6 * math.exp(-0.3 * layer)


def rmsnorm(x, gain):
    x32 = x.astype(jnp.float32)
    y = x32 * lax.rsqrt(jnp.mean(x32 * x32, axis=-1, keepdims=True) + EPS)
    return (y * gain.astype(jnp.float32)).astype(x.dtype)


def t5_bucket(rel):
    half = NUM_BUCKETS // 2
    max_exact = half // 2
    n = jnp.abs(rel)
    large = max_exact + (jnp.log(jnp.maximum(n, 1).astype(jnp.float32) / max_exact)
                         / math.log(MAX_DISTANCE / max_exact) * (half - max_exact)).astype(jnp.int32)
    large = jnp.minimum(large, half - 1)
    return jnp.where(rel > 0, half, 0) + jnp.where(n < max_exact, n, large)


def diff_attention(q, k, v, rel_bias, lam):
    b, s = q.shape[0], q.shape[1]
    n_blocks = s // Q_BLOCK
    q_blocks = q.reshape(b, n_blocks, Q_BLOCK, DA_HEADS, 2, DA_HEAD_DIM).swapaxes(0, 1)
    k1, k2 = k[..., 0, :], k[..., 1, :]
    k_pos = jnp.arange(s)
    scale = DA_HEAD_DIM ** -0.5

    def block(args):
        i, qb = args
        q_pos = i * Q_BLOCK + jnp.arange(Q_BLOCK)
        bias = rel_bias[t5_bucket(k_pos[None, :] - q_pos[:, None])].astype(jnp.float32).transpose(2, 0, 1)
        allowed = (k_pos[None, :] // CHUNK) <= (q_pos[:, None] // CHUNK)

        def probs(qh, kh):
            logits = jnp.einsum('bqhd,bkhd->bhqk', qh, kh).astype(jnp.float32) * scale + bias
            return jax.nn.softmax(jnp.where(allowed, logits, -jnp.inf), axis=-1)

        attn = probs(qb[..., 0, :], k1) - lam * probs(qb[..., 1, :], k2)
        return jnp.einsum('bhqk,bkhe->bqhe', attn.astype(v.dtype), v)

    out = lax.map(block, (jnp.arange(n_blocks), q_blocks))
    return out.swapaxes(0, 1).reshape(b, s, DA_HEADS, 2 * DA_HEAD_DIM)


def linear_scan_combine(left, right):
    a_l, b_l = left
    a_r, b_r = right
    return a_l * a_r, a_r * b_l + b_r


def rg_lru_branch(xr, conv_w, conv_b, ga_w, ga_b, gx_w, gx_b, rg_lambda):
    b, s, _ = xr.shape
    xc = lax.conv_general_dilated(xr, conv_w[:, None, :].astype(xr.dtype), window_strides=(1,),
                                  padding=[(CONV_WIDTH - 1, 0)], dimension_numbers=('NWC', 'WIO', 'NWC'),
                                  feature_group_count=RNN_WIDTH) + conv_b
    xb = xc.reshape(b, s, RNN_BLOCKS, RNN_BLOCK)
    gate_a = jax.nn.sigmoid(jnp.einsum('bsgi,gij->bsgj', xb, ga_w).reshape(b, s, RNN_WIDTH) + ga_b)
    gate_x = jax.nn.sigmoid(jnp.einsum('bsgi,gij->bsgj', xb, gx_w).reshape(b, s, RNN_WIDTH) + gx_b)
    log_a = -RG_C * gate_a.astype(jnp.float32) * jax.nn.softplus(-rg_lambda.astype(jnp.float32))
    a = jnp.exp(log_a)
    u = (xc * gate_x).astype(jnp.float32) * jnp.sqrt(-jnp.expm1(2.0 * log_a))
    _, h = lax.associative_scan(linear_scan_combine, (a, u), axis=1)
    return h.astype(xr.dtype)


def memory_cross_attention(h, mem, mem_gain, wq, wk, wv, q_gain, k_gain, wo):
    b, s, _ = h.shape
    m = rmsnorm(mem, mem_gain)
    q = rmsnorm((h @ wq).reshape(b, s, X_HEADS, X_HEAD_DIM), q_gain)
    k = rmsnorm((m @ wk).reshape(b, -1, X_HEADS, X_HEAD_DIM), k_gain)
    v = (m @ wv).reshape(b, -1, X_HEADS, X_HEAD_DIM)
    logits = jnp.einsum('bqhd,bkhd->bhqk', q, k).astype(jnp.float32) * (X_HEAD_DIM ** -0.5)
    p = jax.nn.softmax(logits, axis=-1)
    o = jnp.einsum('bhqk,bkhd->bqhd', p.astype(v.dtype), v).reshape(b, s, X_WIDTH)
    return o @ wo


def setup_inputs(seed: int = 0) -> dict:
    key = jax.random.key(seed)
    ks = jax.random.split(key, 32)
    L = DEPTH

    def nrm(k, shape, scale):
        return jax.random.normal(k, shape, jnp.float32) * scale

    def gain(k, shape):
        return 1.0 + 0.02 * jax.random.normal(k, shape, jnp.float32)

    u = jax.random.uniform(ks[18], (L, RNN_WIDTH), jnp.float32, minval=0.9, maxval=0.999)
    a0 = u ** (1.0 / RG_C)
    rg_lambda = jnp.log(a0) - jnp.log1p(-a0)
    return {
        'x': nrm(ks[0], (BATCH, SEQ, D_MODEL), 1.0),
        'mem': nrm(ks[1], (BATCH, MEM_LEN, D_MODEL), 1.0),
        'rel_bias': nrm(ks[2], (NUM_BUCKETS, DA_HEADS), 0.2),
        'attn_norm': gain(ks[3], (L, D_MODEL)),
        'w_in': nrm(ks[4], (L, D_MODEL, IN_WIDTH), D_MODEL ** -0.5),
        'da_q_norm': gain(ks[5], (L, DA_HEAD_DIM)),
        'da_k_norm': gain(ks[6], (L, DA_HEAD_DIM)),
        'da_lambda_q1': nrm(ks[7], (L, DA_HEAD_DIM), 0.1),
        'da_lambda_k1': nrm(ks[8], (L, DA_HEAD_DIM), 0.1),
        'da_lambda_q2': nrm(ks[9], (L, DA_HEAD_DIM), 0.1),
        'da_lambda_k2': nrm(ks[10], (L, DA_HEAD_DIM), 0.1),
        'da_subln': gain(ks[11], (L, 2 * DA_HEAD_DIM)),
        'conv_w': nrm(ks[12], (L, CONV_WIDTH, RNN_WIDTH), CONV_WIDTH ** -0.5),
        'conv_b': nrm(ks[13], (L, RNN_WIDTH), 0.01),
        'gate_a_w': nrm(ks[14], (L, RNN_BLOCKS, RNN_BLOCK, RNN_BLOCK), RNN_BLOCK ** -0.5),
        'gate_a_b': nrm(ks[15], (L, RNN_WIDTH), 0.01),
        'gate_x_w': nrm(ks[16], (L, RNN_BLOCKS, RNN_BLOCK, RNN_BLOCK), RNN_BLOCK ** -0.5),
        'gate_x_b': nrm(ks[17], (L, RNN_WIDTH), 0.01),
        'rg_lambda': rg_lambda,
        'rnn_out_norm': gain(ks[19], (L, RNN_WIDTH)),
        'w_out': nrm(ks[20], (L, MIX_WIDTH, D_MODEL), MIX_WIDTH ** -0.5),
        'xattn_norm': gain(ks[21], (L, D_MODEL)),
        'mem_norm': gain(ks[22], (L, D_MODEL)),
        'xq_w': nrm(ks[23], (L, D_MODEL, X_WIDTH), D_MODEL ** -0.5),
        'xk_w': nrm(ks[24], (L, D_MODEL, X_WIDTH), D_MODEL ** -0.5),
        'xv_w': nrm(ks[25], (L, D_MODEL, X_WIDTH), D_MODEL ** -0.5),
        'xq_norm': gain(ks[26], (L, X_HEAD_DIM)),
        'xk_norm': gain(ks[27], (L, X_HEAD_DIM)),
        'xo_w': nrm(ks[28], (L, X_WIDTH, D_MODEL), X_WIDTH ** -0.5),
        'ffn_norm': gain(ks[29], (L, D_MODEL)),
        'w_gate_up': nrm(ks[30], (L, D_MODEL, 2 * D_FF), D_MODEL ** -0.5),
        'w_down': nrm(ks[31], (L, D_FF, D_MODEL), D_FF ** -0.5),
    }


def reference(x, mem, rel_bias, attn_norm, w_in, da_q_norm, da_k_norm, da_lambda_q1, da_lambda_k1,
              da_lambda_q2, da_lambda_k2, da_subln, conv_w, conv_b, gate_a_w, gate_a_b, gate_x_w, gate_x_b,
              rg_lambda, rnn_out_norm, w_out, xattn_norm, mem_norm, xq_w, xk_w, xv_w, xq_norm, xk_norm,
              xo_w, ffn_norm, w_gate_up, w_down):
    b, s, _ = x.shape
    for l in range(DEPTH):
        lam_init = lambda_init(l)
        h = rmsnorm(x, attn_norm[l])
        proj = h @ w_in[l]
        q, k, v, xr, yr = jnp.split(proj, [ATTN_WIDTH, 2 * ATTN_WIDTH, 3 * ATTN_WIDTH,
                                           3 * ATTN_WIDTH + RNN_WIDTH], axis=-1)
        q = rmsnorm(q.reshape(b, s, DA_HEADS, 2, DA_HEAD_DIM), da_q_norm[l])
        k = rmsnorm(k.reshape(b, s, DA_HEADS, 2, DA_HEAD_DIM), da_k_norm[l])
        v = v.reshape(b, s, DA_HEADS, 2 * DA_HEAD_DIM)
        f32 = jnp.float32
        lam = (jnp.exp(jnp.sum(da_lambda_q1[l].astype(f32) * da_lambda_k1[l].astype(f32)))
               - jnp.exp(jnp.sum(da_lambda_q2[l].astype(f32) * da_lambda_k2[l].astype(f32))) + lam_init)
        o_attn = diff_attention(q, k, v, rel_bias, lam)
        o_attn = (rmsnorm(o_attn, da_subln[l]) * (1.0 - lam_init)).reshape(b, s, ATTN_WIDTH)
        h_rnn = rg_lru_branch(xr, conv_w[l], conv_b[l], gate_a_w[l], gate_a_b[l], gate_x_w[l],
                              gate_x_b[l], rg_lambda[l])
        o_rnn = rmsnorm(h_rnn * jax.nn.gelu(yr), rnn_out_norm[l])
        x = x + jnp.concatenate([o_attn, o_rnn], axis=-1) @ w_out[l]
        x = x + memory_cross_attention(rmsnorm(x, xattn_norm[l]), mem, mem_norm[l], xq_w[l], xk_w[l],
                                       xv_w[l], xq_norm[l], xk_norm[l], xo_w[l])
        g, u = jnp.split(rmsnorm(x, ffn_norm[l]) @ w_gate_up[l], 2, axis=-1)
        x = x + (jax.nn.silu(g) * u) @ w_down[l]
    return x
```

```cpp
#include <hip/hip_runtime.h>
#include <hip/hip_cooperative_groups.h>
#include <cstdio>
#include <cstdint>
namespace cg = cooperative_groups;
#define LAS __attribute__((address_space(3)))
namespace pg8 {
#define PG8_LAS __attribute__((address_space(3)))
typedef unsigned short bf16_t;
typedef short bf16x8 __attribute__((ext_vector_type(8)));
typedef float f32x4 __attribute__((ext_vector_type(4)));
typedef unsigned u32x4 __attribute__((ext_vector_type(4)));
constexpr int BM = 256, BK = 64, HALF = 128, HTB = HALF * BK * 2  , STAGE_BYTES = 8 * HTB, NXCD = 8, WGM = 8;

__host__ __device__ __forceinline__ int lds_byte(int r, int c) { const int st = (r >> 4) * 2 + (c >> 5), rr = r & 15, cc = c & 31, ob = rr * 64 + cc * 2; return st * 1024 + (ob ^ (((ob >> 9) & 1) << 5)); }
__host__ __device__ __forceinline__ void stage_rc(int b, int& R, int& C) { const int st = b / 1024, sb = b % 1024, swz = sb ^ (((sb >> 9) & 1) << 5); R = (st >> 1) * 16 + swz / 64; C = (st & 1) * 32 + (swz % 64) / 2; }
__host__ __device__ __forceinline__ int perm32(int rho) { const int n = rho >> 4, i = rho & 15; return 8 * (i >> 2) + 4 * n + (i & 3); }

struct Unit { int pm, pn; };
struct Gemm { const bf16_t* A; const bf16_t* Bt; int M, N, K, lda, ldb; long apn; };

struct StaticOrder {
    int nM, nN, nwg, G, c;
    __host__ __device__ void init(int M, int N, int G_, int c_) { nM = M / BM; nN = N / BM; nwg = nM * nN; G = G_; c = c_; }
    __host__ __device__ bool next(int i, Unit& u) const {
        const long L = (long)i * G + c; if (L >= nwg) return false;
        int wgid = (int)L; { const int q = nwg / NXCD, r = nwg % NXCD, xcd = wgid % NXCD, off = wgid / NXCD; wgid = (xcd < r ? xcd * (q + 1) : r * (q + 1) + (xcd - r) * q) + off; }
        const int nig = WGM * nN, gid = wgid / nig, fm = gid * WGM, gsz = (nM - fm) < WGM ? (nM - fm) : WGM;
        u.pm = fm + ((wgid % nig) % gsz); u.pn = (wgid % nig) / gsz; return true;
    }
    __device__ __forceinline__ void a_ready(const Unit&) const {}
    __device__ __forceinline__ void done(const Unit&) const {}
};

typedef unsigned u32x2 __attribute__((ext_vector_type(2)));
typedef float f32x16 __attribute__((ext_vector_type(16)));
typedef __bf16 bf16x2_t __attribute__((ext_vector_type(2)));
typedef float f32x2_t __attribute__((ext_vector_type(2)));
__device__ __forceinline__ unsigned cvt_pk_bf16(float lo, float hi) { const f32x2_t v = {lo, hi}; const bf16x2_t b = __builtin_convertvector(v, bf16x2_t); return __builtin_bit_cast(unsigned, b); }
__device__ __forceinline__ u32x4 pack8(const f32x4 a, const f32x4 b) { u32x4 w; w.x = cvt_pk_bf16(a[0], a[1]); w.y = cvt_pk_bf16(a[2], a[3]); w.z = cvt_pk_bf16(b[0], b[1]); w.w = cvt_pk_bf16(b[2], b[3]); return w; }
__device__ __forceinline__ float bf_lo(unsigned w) { return __uint_as_float(w << 16); }
__device__ __forceinline__ float bf_hi(unsigned w) { return __uint_as_float(w & 0xffff0000u); }
constexpr float EPSF = 1e-6f, LOG2E = 1.4426950408889634f;

struct EpiIn {
    static constexpr bool PERM = true, AFTER_DRAIN = false;
    const float* rstd; bf16_t *q, *k, *xr, *yr; const float *qg, *kg; float qscale;
    __device__ __forceinline__ void operator()(const f32x4 (&acc)[2][2][4][2], const Unit& u, int wr, int wc, int fr, int fq) const {
        const int region = u.pn >> 2;
        const int lc0 = (u.pn & 3) * 256 + wc * 64 + fq * 8;
        bf16_t* dst = q + (size_t)region * (16u << 20) + (region >= 2 ? (size_t)(16u << 20) : (size_t)0);
        const bool nrm = region < 2;
        f32x4 g[2][2];
#pragma unroll
        for (int bj = 0; bj < 2; ++bj)
#pragma unroll
            for (int n = 0; n < 2; ++n) g[bj][n] = (f32x4){1.f, 1.f, 1.f, 1.f};
        if (nrm) { const float* gp = region == 0 ? qg : kg; const float sc = region == 0 ? qscale : 1.f;
#pragma unroll
            for (int bj = 0; bj < 2; ++bj)
#pragma unroll
                for (int n = 0; n < 2; ++n) g[bj][n] = *(const f32x4*)(gp + 32 * bj + fq * 8 + 4 * n) * sc; }
#pragma unroll
        for (int ai = 0; ai < 2; ++ai)
#pragma unroll
            for (int m = 0; m < 4; ++m) {
                const int row = u.pm * BM + ai * HALF + wr * 64 + m * 16 + fr; const float rs = rstd[row];
                f32x4 v[2][2]; float ss = 0.f;
#pragma unroll
                for (int bj = 0; bj < 2; ++bj)
#pragma unroll
                    for (int n = 0; n < 2; ++n) { v[bj][n] = acc[ai][bj][m][n] * rs; const f32x4 t = v[bj][n] * v[bj][n]; ss += (t[0] + t[1]) + (t[2] + t[3]); }
                float r = 1.f;
                if (nrm) { ss += __shfl_xor(ss, 16); ss += __shfl_xor(ss, 32); r = rsqrtf(ss * (1.f / 64.f) + EPSF); }
#pragma unroll
                for (int bj = 0; bj < 2; ++bj) { const u32x4 w = pack8(v[bj][0] * g[bj][0] * r, v[bj][1] * g[bj][1] * r);
                    *(u32x4*)(dst + (size_t)row * 1024 + lc0 + 32 * bj) = w; }
            }
    }
};
struct EpiVT {
    static constexpr bool PERM = true, AFTER_DRAIN = false;
    const float* rstd; bf16_t* vT;
    __device__ __forceinline__ void operator()(const f32x4 (&acc)[2][2][4][2], const Unit& u, int wr, int wc, int fr, int fq) const {
        f32x4 rs[2][2];
#pragma unroll
        for (int bj = 0; bj < 2; ++bj)
#pragma unroll
            for (int n = 0; n < 2; ++n) rs[bj][n] = *(const f32x4*)(rstd + u.pn * BM + bj * HALF + wc * 32 + fq * 8 + 4 * n);
#pragma unroll
        for (int ai = 0; ai < 2; ++ai)
#pragma unroll
            for (int m = 0; m < 4; ++m) { const int row = u.pm * BM + ai * HALF + wr * 64 + m * 16 + fr;
#pragma unroll
                for (int bj = 0; bj < 2; ++bj) *(u32x4*)(vT + (size_t)row * 16384 + u.pn * BM + bj * HALF + wc * 32 + fq * 8) = pack8(acc[ai][bj][m][0] * rs[bj][0], acc[ai][bj][m][1] * rs[bj][1]); }
    }
};
__device__ __forceinline__ float row_rstd32(const float* ssqp, int row, int fq) {
    const f32x4 a = *(const f32x4*)(ssqp + ((size_t)(2 * fq) * 16384 + row) * 4), b = *(const f32x4*)(ssqp + ((size_t)(2 * fq + 1) * 16384 + row) * 4);
    float s = ((a[0] + a[1]) + (a[2] + a[3])) + ((b[0] + b[1]) + (b[2] + b[3]));
    s += __shfl_xor(s, 16); s += __shfl_xor(s, 32);
    return rsqrtf(s * (1.f / 2048.f) + EPSF);
}
template <bool F32OUT> struct EpiPlain {
    static constexpr bool PERM = true, AFTER_DRAIN = false;
    void* out; int ldc; const float* ssq;
    __device__ __forceinline__ void operator()(const f32x4 (&acc)[2][2][4][2], const Unit& u, int wr, int wc, int fr, int fq) const {
#pragma unroll
        for (int ai = 0; ai < 2; ++ai)
#pragma unroll
            for (int m = 0; m < 4; ++m) { const int row = u.pm * BM + ai * HALF + wr * 64 + m * 16 + fr;
                const float rs = ssq ? row_rstd32(ssq, row, fq) : 1.f;
#pragma unroll
                for (int bj = 0; bj < 2; ++bj) { const size_t off = (size_t)row * ldc + u.pn * BM + bj * HALF + wc * 32 + fq * 8;
                    if (F32OUT) { *(f32x4*)((float*)out + off) = acc[ai][bj][m][0] * rs; *(f32x4*)((float*)out + off + 4) = acc[ai][bj][m][1] * rs; }
                    else *(u32x4*)((bf16_t*)out + off) = pack8(acc[ai][bj][m][0] * rs, acc[ai][bj][m][1] * rs); } }
    }
};
template <bool BASE_BF16, bool OUT_BF16> struct EpiRes {
    static constexpr bool PERM = true, AFTER_DRAIN = false;
    const void* base; void* out; float* ssq;
    __device__ __forceinline__ void operator()(const f32x4 (&acc)[2][2][4][2], const Unit& u, int wr, int wc, int fr, int fq) const {
#pragma unroll
        for (int ai = 0; ai < 2; ++ai)
#pragma unroll
            for (int m = 0; m < 4; ++m) { const int row = u.pm * BM + ai * HALF + wr * 64 + m * 16 + fr; float ss = 0.f;
#pragma unroll
                for (int bj = 0; bj < 2; ++bj) { const size_t off = (size_t)row * 2048 + u.pn * BM + bj * HALF + wc * 32 + fq * 8;
                    f32x4 b0, b1;
                    if (BASE_BF16) { const u32x4 w = *(const u32x4*)((const bf16_t*)base + off); b0 = (f32x4){bf_lo(w.x), bf_hi(w.x), bf_lo(w.y), bf_hi(w.y)}; b1 = (f32x4){bf_lo(w.z), bf_hi(w.z), bf_lo(w.w), bf_hi(w.w)}; }
                    else { b0 = *(const f32x4*)((const float*)base + off); b1 = *(const f32x4*)((const float*)base + off + 4); }
                    const f32x4 v0 = b0 + acc[ai][bj][m][0], v1 = b1 + acc[ai][bj][m][1];
                    if (OUT_BF16) *(u32x4*)((bf16_t*)out + off) = pack8(v0, v1);
                    else { *(f32x4*)((float*)out + off) = v0; *(f32x4*)((float*)out + off + 4) = v1; }
                    const f32x4 t0 = v0 * v0, t1 = v1 * v1; ss += ((t0[0] + t0[1]) + (t0[2] + t0[3])) + ((t1[0] + t1[1]) + (t1[2] + t1[3])); }
                if (ssq) { ss += __shfl_xor(ss, 16); ss += __shfl_xor(ss, 32); if (fq == 0) ssq[((size_t)u.pn * 16384 + row) * 4 + wc] = ss; }
            }
    }
};
struct EpiGU {
    static constexpr bool PERM = true, AFTER_DRAIN = false;
    const float* ssq; bf16_t* hid;
    __device__ __forceinline__ void operator()(const f32x4 (&acc)[2][2][4][2], const Unit& u, int wr, int wc, int fr, int fq) const {
#pragma unroll
        for (int ai = 0; ai < 2; ++ai)
#pragma unroll
            for (int m = 0; m < 4; ++m) { const int row = u.pm * BM + ai * HALF + wr * 64 + m * 16 + fr;
                const float rs = row_rstd32(ssq, row, fq);
                f32x4 hv[2];
#pragma unroll
                for (int n = 0; n < 2; ++n) { const f32x4 gg = acc[ai][0][m][n] * rs, uu = acc[ai][1][m][n] * rs;
#pragma unroll
                    for (int e = 0; e < 4; ++e) hv[n][e] = gg[e] * __builtin_amdgcn_rcpf(1.f + __builtin_amdgcn_exp2f(-gg[e] * LOG2E)) * uu[e]; }
                *(u32x4*)(hid + (size_t)row * 5632 + u.pn * 128 + wc * 32 + fq * 8) = pack8(hv[0], hv[1]); }
    }
};
struct EpiGate {
    static constexpr bool PERM = true, AFTER_DRAIN = false;
    const bf16_t* xc; const float *ga_b, *gx_b, *spl; bf16_t *la, *uo;
    __device__ __forceinline__ void operator()(const f32x4 (&acc)[2][2][4][2], const Unit& u, int wr, int wc, int fr, int fq) const {
        const int c0 = u.pn * 128 + wc * 32 + fq * 8;
#pragma unroll
        for (int n = 0; n < 2; ++n) {
            const f32x4 ba = *(const f32x4*)(ga_b + c0 + 4 * n), bx = *(const f32x4*)(gx_b + c0 + 4 * n), sp = *(const f32x4*)(spl + c0 + 4 * n);
            u32x2 xws[2][4];
#pragma unroll
            for (int ai = 0; ai < 2; ++ai)
#pragma unroll
                for (int m = 0; m < 4; ++m) xws[ai][m] = *(const u32x2*)(xc + (size_t)(u.pm * BM + ai * HALF + wr * 64 + m * 16 + fr) * 1024 + c0 + 4 * n);
#pragma unroll
            for (int ai = 0; ai < 2; ++ai)
#pragma unroll
                for (int m = 0; m < 4; ++m) { const int row = u.pm * BM + ai * HALF + wr * 64 + m * 16 + fr;
                    const u32x2 xw = xws[ai][m];
                    const f32x4 xv = (f32x4){bf_lo(xw.x), bf_hi(xw.x), bf_lo(xw.y), bf_hi(xw.y)};
                    const f32x4 pa = acc[ai][0][m][n] + ba, px = acc[ai][1][m][n] + bx;
                    f32x4 lv, uv;
#pragma unroll
                    for (int e = 0; e < 4; ++e) {
                        const float ga = __builtin_amdgcn_rcpf(1.f + __builtin_amdgcn_exp2f(-pa[e] * LOG2E));
                        const float gx = __builtin_amdgcn_rcpf(1.f + __builtin_amdgcn_exp2f(-px[e] * LOG2E));
                        const float l2 = -ga * sp[e];
                        const float xl = 2.f * l2 * 0.6931471805599453f;
                        const float om = xl > -0.02f ? -(xl + xl * xl * (0.5f + xl * (1.f / 6.f))) : 1.f - __builtin_amdgcn_exp2f(2.f * l2);
                        lv[e] = l2; uv[e] = xv[e] * gx * __builtin_amdgcn_sqrtf(om); }
                    u32x2 lo, uo2; lo.x = cvt_pk_bf16(lv[0], lv[1]); lo.y = cvt_pk_bf16(lv[2], lv[3]); uo2.x = cvt_pk_bf16(uv[0], uv[1]); uo2.y = cvt_pk_bf16(uv[2], uv[3]);
                    *(u32x2*)(la + (size_t)row * 1024 + c0 + 4 * n) = lo;
                    *(u32x2*)(uo + (size_t)row * 1024 + c0 + 4 * n) = uo2; }
            asm volatile("" ::: "memory");
        }
    }
};

template <class Epi, class Sched, bool ALIGN_EPI = false, bool SP2 = false>
__device__ __forceinline__ void gemm_phase(PG8_LAS unsigned char* lds, const Gemm g, const Sched& S, const Epi& E) {
    int tid_ = threadIdx.x; asm volatile("" : "+v"(tid_));
    const int tid = tid_, wid = __builtin_amdgcn_readfirstlane(tid >> 6), lane = tid & 63, wr = wid >> 2, wc = wid & 3, fr = lane & 15, fq = lane >> 4;
    const int K = g.K, nt = K / BK;
    unsigned voffA[2], voffB[2];
#pragma unroll
    for (int i = 0; i < 2; ++i) { int R, C; stage_rc(tid * 16 + i * 8192, R, C); const int Rb = Epi::PERM ? ((R & ~31) + perm32(R & 31)) : R;
        voffA[i] = (unsigned)(R * g.lda + C) * 2u; voffB[i] = (unsigned)(Rb * g.ldb + C) * 2u; }
    const size_t kstep = (size_t)(BK * 2);
    const size_t hstepA = (size_t)HALF * g.lda * 2, hstepB = (size_t)HALF * g.ldb * 2;
    const size_t tstepA = 2 * hstepA, tstepB = 2 * hstepB, apnb = (size_t)g.apn * 2;
    const unsigned ldsw = (unsigned)wid * 1024u;
    const int aoff = lds_byte(wr * 64 + fr, fq * 8), boff = lds_byte(wc * 32 + fr, fq * 8);
#define PG8_SA(b, h) (((b) * 2 + (h)) * HTB)
#define PG8_SB(b, h) ((4 + (b) * 2 + (h)) * HTB)
#define PG8_STAGE(bufoff, gbase, voff) do { _Pragma("unroll") for (int _i = 0; _i < 2; ++_i) \
        __builtin_amdgcn_global_load_lds((const unsigned*)((const char*)(gbase) + (voff)[_i]), (PG8_LAS unsigned*)(lds + (bufoff) + ldsw + _i * 8192), 16, 0, 0); } while (0)
#define PG8_LDA(dst, b, h) do { _Pragma("unroll") for (int m = 0; m < 4; ++m) _Pragma("unroll") for (int k = 0; k < 2; ++k) dst[m][k] = *(const PG8_LAS bf16x8*)(lds + PG8_SA(b, h) + aoff + m * 2048 + k * 1024); } while (0)
#define PG8_LDB(dst, b, h) do { _Pragma("unroll") for (int n = 0; n < 2; ++n) _Pragma("unroll") for (int k = 0; k < 2; ++k) dst[n][k] = *(const PG8_LAS bf16x8*)(lds + PG8_SB(b, h) + boff + n * 2048 + k * 1024); } while (0)
#define PG8_MMA(ai, bj, At, Bt) do { __builtin_amdgcn_s_setprio(1); _Pragma("unroll") for (int m = 0; m < 4; ++m) _Pragma("unroll") for (int n = 0; n < 2; ++n) _Pragma("unroll") for (int k = 0; k < 2; ++k) \
        acc[ai][bj][m][n] = __builtin_amdgcn_mfma_f32_16x16x32_bf16(Bt[n][k], At[m][k], acc[ai][bj][m][n], 0, 0, 0); __builtin_amdgcn_s_setprio(0); } while (0)
#define PG8_WAIT_V(n) asm volatile("s_waitcnt vmcnt(" #n ")" ::: "memory")
#define PG8_WAIT_L(n) asm volatile("s_waitcnt lgkmcnt(" #n ")" ::: "memory")
#define PG8_BAR __builtin_amdgcn_s_barrier()
#define PG8_SCHED __builtin_amdgcn_sched_barrier(0)
    Unit cur, nxt; int ui = 0;
    if (!S.next(0, cur)) return;
    f32x4 acc[2][2][4][2];
#pragma unroll
    for (int a = 0; a < 2; ++a)
#pragma unroll
        for (int b = 0; b < 2; ++b)
#pragma unroll
            for (int m = 0; m < 4; ++m)
#pragma unroll
                for (int n = 0; n < 2; ++n) acc[a][b][m][n] = (f32x4){0.f, 0.f, 0.f, 0.f};
    bf16x8 At[4][2], B0[2][2], B1[2][2];
    const char* cA = (const char*)g.A + (size_t)cur.pm * tstepA + (size_t)cur.pn * apnb; const char* cB = (const char*)g.Bt + (size_t)cur.pn * tstepB;
    S.a_ready(cur);
    if constexpr (SP2) {
        PG8_STAGE(PG8_SB(0, 0), cB, voffB); PG8_STAGE(PG8_SB(0, 1), cB + hstepB, voffB); PG8_STAGE(PG8_SA(0, 0), cA, voffA); PG8_STAGE(PG8_SA(0, 1), cA + hstepA, voffA);
        if (wr == 1) PG8_BAR;
        PG8_WAIT_V(2); PG8_BAR;
        PG8_STAGE(PG8_SB(1, 0), cB + kstep, voffB); PG8_STAGE(PG8_SA(1, 0), cA + kstep, voffA); PG8_STAGE(PG8_SB(1, 1), cB + hstepB + kstep, voffB);
        PG8_WAIT_V(6); PG8_BAR;
    } else {
        PG8_STAGE(PG8_SB(0, 0), cB, voffB); PG8_STAGE(PG8_SA(0, 0), cA, voffA); PG8_STAGE(PG8_SB(0, 1), cB + hstepB, voffB); PG8_STAGE(PG8_SA(0, 1), cA + hstepA, voffA);
        if (wr == 1) PG8_BAR;
        PG8_WAIT_V(4); PG8_BAR;
        PG8_STAGE(PG8_SB(1, 0), cB + kstep, voffB); PG8_STAGE(PG8_SA(1, 0), cA + kstep, voffA); PG8_STAGE(PG8_SB(1, 1), cB + hstepB + kstep, voffB);
        PG8_WAIT_V(6); PG8_BAR;
    }
    for (;;) {
        const bool has_next = S.next(ui + 1, nxt);
        const char* nA = has_next ? (const char*)g.A + (size_t)nxt.pm * tstepA + (size_t)nxt.pn * apnb : cA; const char* nB = has_next ? (const char*)g.Bt + (size_t)nxt.pn * tstepB : cB;
        for (int t = 0; t < nt; t += 2) {
            const bool last = (t == nt - 2);
            const char* a1 = cA + (size_t)(t + 1) * kstep;
            const char* a2 = last ? nA : cA + (size_t)(t + 2) * kstep; const char* b2 = last ? nB : cB + (size_t)(t + 2) * kstep;
            const char* a3 = a2 + kstep; const char* b3 = b2 + kstep;
            if (last && has_next) S.a_ready(nxt);
            if constexpr (SP2) {
            PG8_LDB(B0, 0, 0); PG8_LDB(B1, 0, 1); PG8_SCHED; PG8_LDA(At, 0, 0); PG8_STAGE(PG8_SA(1, 1), a1 + hstepA, voffA);
            PG8_WAIT_V(8); PG8_WAIT_L(0); PG8_BAR; PG8_MMA(0, 0, At, B0); PG8_MMA(0, 1, At, B1); PG8_BAR; PG8_SCHED;
            PG8_LDA(At, 0, 1); PG8_STAGE(PG8_SB(0, 0), b2, voffB); PG8_STAGE(PG8_SB(0, 1), b2 + hstepB, voffB); PG8_STAGE(PG8_SA(0, 0), a2, voffA);
            PG8_WAIT_V(8); PG8_WAIT_L(0); PG8_BAR; PG8_MMA(1, 0, At, B0); PG8_MMA(1, 1, At, B1); PG8_BAR; PG8_SCHED;
            PG8_LDB(B0, 1, 0); PG8_LDB(B1, 1, 1); PG8_SCHED; PG8_LDA(At, 1, 0); PG8_STAGE(PG8_SA(0, 1), a2 + hstepA, voffA);
            PG8_WAIT_V(8); PG8_WAIT_L(0); PG8_BAR; PG8_MMA(0, 0, At, B0); PG8_MMA(0, 1, At, B1); PG8_BAR; PG8_SCHED;
            PG8_LDA(At, 1, 1); PG8_STAGE(PG8_SB(1, 0), b3, voffB); PG8_STAGE(PG8_SB(1, 1), b3 + hstepB, voffB); PG8_STAGE(PG8_SA(1, 0), a3, voffA);
            PG8_WAIT_V(8); PG8_WAIT_L(0); PG8_BAR; PG8_MMA(1, 0, At, B0); PG8_MMA(1, 1, At, B1); PG8_BAR; PG8_SCHED;
            } else {
            PG8_LDB(B0, 0, 0); PG8_SCHED; PG8_LDA(At, 0, 0); PG8_STAGE(PG8_SA(1, 1), a1 + hstepA, voffA);
            PG8_WAIT_L(8); PG8_BAR; PG8_WAIT_L(0); PG8_MMA(0, 0, At, B0); PG8_BAR; PG8_SCHED;
            PG8_LDB(B1, 0, 1); PG8_STAGE(PG8_SB(0, 0), b2, voffB);
            PG8_BAR; PG8_WAIT_L(0); PG8_MMA(0, 1, At, B1); PG8_BAR;
            PG8_LDA(At, 0, 1); PG8_STAGE(PG8_SA(0, 0), a2, voffA);
            PG8_BAR; PG8_WAIT_L(0); PG8_MMA(1, 0, At, B0); PG8_BAR; PG8_SCHED;
            PG8_STAGE(PG8_SB(0, 1), b2 + hstepB, voffB);
            PG8_WAIT_V(6); PG8_BAR; PG8_MMA(1, 1, At, B1); PG8_BAR;
            PG8_LDB(B0, 1, 0); PG8_SCHED; PG8_LDA(At, 1, 0); PG8_STAGE(PG8_SA(0, 1), a2 + hstepA, voffA);
            PG8_WAIT_L(8); PG8_BAR; PG8_WAIT_L(0); PG8_MMA(0, 0, At, B0); PG8_BAR; PG8_SCHED;
            PG8_LDB(B1, 1, 1); PG8_STAGE(PG8_SB(1, 0), b3, voffB);
            PG8_BAR; PG8_WAIT_L(0); PG8_MMA(0, 1, At, B1); PG8_BAR;
            PG8_LDA(At, 1, 1); PG8_STAGE(PG8_SA(1, 0), a3, voffA);
            PG8_BAR; PG8_WAIT_L(0); PG8_MMA(1, 0, At, B0); PG8_BAR; PG8_SCHED;
            PG8_STAGE(PG8_SB(1, 1), b3 + hstepB, voffB);
            PG8_WAIT_V(6); PG8_BAR; PG8_MMA(1, 1, At, B1); PG8_BAR;
            }
        }
        if constexpr (ALIGN_EPI) { if (wr == 0) PG8_BAR; }
        if constexpr (!Epi::AFTER_DRAIN) { E(acc, cur, wr, wc, fr, fq); S.done(cur); }
        if (!has_next) break;
#pragma unroll
        for (int a = 0; a < 2; ++a)
#pragma unroll
            for (int b = 0; b < 2; ++b)
#pragma unroll
                for (int m = 0; m < 4; ++m)
#pragma unroll
                    for (int n = 0; n < 2; ++n) acc[a][b][m][n] = (f32x4){0.f, 0.f, 0.f, 0.f};
        cur = nxt; cA = nA; cB = nB; ++ui;
        if constexpr (ALIGN_EPI) { if (wr == 1) PG8_BAR; }
    }
    PG8_WAIT_V(0);
    if constexpr (!ALIGN_EPI) { if (wr == 0) PG8_BAR; }
    PG8_BAR;
    if constexpr (Epi::AFTER_DRAIN) { E.fused(acc, cur, wr, wc, fr, fq, lds, wid, lane); S.done(cur); }
#undef PG8_SA
#undef PG8_SB
#undef PG8_STAGE
#undef PG8_LDA
#undef PG8_LDB
#undef PG8_MMA
#undef PG8_WAIT_V
#undef PG8_WAIT_L
#undef PG8_BAR
#undef PG8_SCHED
}
}
using namespace pg8;
#define GLOBAL_AS __attribute__((address_space(1)))
constexpr int SEQ = 16384, DM = 2048, AW = 1024, RW = 1024, INW = 5120, XW = 512, DFF = 5632, MEML = 256;
constexpr int NTHREADS = 512, NWAVES = 8;
constexpr int LDS_BYTES = 147456;
constexpr size_t KiB = 1024, MiB = 1u << 20;
constexpr size_t WS_RSTD1 = 0, WS_SSQ2 = 64 * KiB, WS_SSQ3 = 128 * KiB, WS_SPL = 192 * KiB, WS_BAR = 208 * KiB  , WS_MKRAW = 256 * KiB, WS_MKN = 768 * KiB, WS_MVT = 1 * MiB;
constexpr size_t WS_MEMN = 2 * MiB, WS_AS = 3 * MiB, WS_HEND = 4 * MiB, WS_WGATE = 5 * MiB, WS_WA = 6 * MiB, WS_WV = 22 * MiB, WS_WOUT = 26 * MiB;
constexpr size_t WS_WXQ = 34 * MiB, WS_WXK = 36 * MiB, WS_WXV = 38 * MiB, WS_WXO = 40 * MiB, WS_WGU = 42 * MiB, WS_WDN = 86 * MiB, WS_XB = 108 * MiB;
constexpr size_t WS_Q = 172 * MiB, WS_K = 204 * MiB, WS_VT = 236 * MiB, WS_XR = 268 * MiB, WS_YR = 300 * MiB, WS_XC = 332 * MiB, WS_HID = 172 * MiB;
constexpr size_t WS_LA = 364 * MiB, WS_U = 396 * MiB, WS_MIX = 428 * MiB, WS_XQ = 364 * MiB, WS_XOIN = 380 * MiB, WS_SSQP2 = 492 * MiB, WS_SSQP3 = 494 * MiB, WS_END = 496 * MiB;

struct Args { const float* in[32]; float* out; unsigned char* ws; };
enum { I_X = 0, I_MEM, I_RELB, I_ATTN_NORM, I_W_IN, I_QN, I_KN, I_LQ1, I_LK1, I_LQ2, I_LK2, I_SUBLN, I_CONV_W, I_CONV_B, I_GA_W, I_GA_B, I_GX_W, I_GX_B,
       I_RGL, I_RNN_NORM, I_W_OUT, I_XATTN_NORM, I_MEM_NORM, I_XQ_W, I_XK_W, I_XV_W, I_XQ_NORM, I_XK_NORM, I_XO_W, I_FFN_NORM, I_W_GU, I_W_DN };

__device__ __forceinline__ float wave_sum(float v) {
#pragma unroll
    for (int o = 1; o < 64; o <<= 1) v += __shfl_xor(v, o);
    return v;
}
#define LDS_WAIT() asm volatile("s_waitcnt lgkmcnt(0)" ::: "memory")

__device__ __forceinline__ void xpose_item(const float* W, int ldw, int csrc, const float* gain, bf16_t* WT, int ldt, int drow, int k0, LAS float* scr, int lane) {
    f32x4 wv[8];
#pragma unroll
    for (int i = 0; i < 8; ++i) wv[i] = __builtin_nontemporal_load((const f32x4*)(W + (size_t)(k0 + 8 * i + (lane >> 3)) * ldw + csrc + (lane & 7) * 4));
    if (gain) {
#pragma unroll
        for (int i = 0; i < 8; ++i) wv[i] = wv[i] * gain[k0 + 8 * i + (lane >> 3)]; }
#pragma unroll
    for (int i = 0; i < 8; ++i) { LAS float* d = scr + (8 * i + (lane >> 3)) * 33 + (lane & 7) * 4; d[0] = wv[i][0]; d[1] = wv[i][1]; d[2] = wv[i][2]; d[3] = wv[i][3]; }
    LDS_WAIT(); asm volatile("" ::: "memory");
    const int c = lane & 7;
#pragma unroll
    for (int j = 0; j < 4; ++j) { const int n = (lane >> 3) + 8 * j; const LAS float* s = scr + (8 * c) * 33 + n;
        u32x4 o; o.x = cvt_pk_bf16(s[0 * 33], s[1 * 33]); o.y = cvt_pk_bf16(s[2 * 33], s[3 * 33]); o.z = cvt_pk_bf16(s[4 * 33], s[5 * 33]); o.w = cvt_pk_bf16(s[6 * 33], s[7 * 33]);
        *(u32x4*)(WT + (size_t)(drow + n) * ldt + k0 + 8 * c) = o; }
    LDS_WAIT(); asm volatile("" ::: "memory");
}
__device__ __forceinline__ float row_to_bf16(const float* xrow, bf16_t* orow, const float* gain, bool normalize, int lane) {
    const f32x4* xr = (const f32x4*)xrow + lane;
    f32x4 v[8]; float s = 0.f;
#pragma unroll
    for (int j = 0; j < 8; ++j) { v[j] = __builtin_nontemporal_load(xr + 64 * j); const f32x4 t = v[j] * v[j]; s += (t[0] + t[1]) + (t[2] + t[3]); }
    const float rstd = rsqrtf(wave_sum(s) * (1.f / 2048.f) + EPSF);
    u32x2* o8 = (u32x2*)orow + lane;
#pragma unroll
    for (int j = 0; j < 8; ++j) { f32x4 w = v[j];
        if (normalize) { const f32x4 g = *((const f32x4*)gain + lane + 64 * j); w = w * rstd * g; }
        u32x2 o; o.x = cvt_pk_bf16(w[0], w[1]); o.y = cvt_pk_bf16(w[2], w[3]); o8[64 * j] = o; }
    return rstd;
}

__device__ __forceinline__ void p0_prologue(const Args& a, LAS unsigned char* lds, int G, int bid, int tid) {
    const int wave = __builtin_amdgcn_readfirstlane(tid >> 6), lane = tid & 63;
    unsigned char* ws = a.ws;
    LAS float* scr = (LAS float*)(lds + wave * 16384);
    const int gw = bid * NWAVES + wave, NGW = G * NWAVES;
    constexpr int J0 = 32 * 160, J1 = 32 * 64, J2 = 32 * 16, J5 = 8 * 64, J6 = 32 * 352, J7 = 88 * 64, J8 = 128;
    constexpr int NITEMS = J0 + J1 + 3 * J2 + J5 + J6 + J8;
    for (int it = gw; it < NITEMS; it += NGW) {
        int r = it;
        if (r < J0) { const int kb = r / 160, ng = r % 160, n0 = 32 * ng, region = n0 >> 10;
            if (region == 2) xpose_item(a.in[I_W_IN], INW, n0, a.in[I_ATTN_NORM], (bf16_t*)(ws + WS_WV), DM, n0 - 2048, 64 * kb, scr, lane);
            else { const int L = n0 - (region > 2 ? 1024 : 0), tile = L >> 8, j = L & 255, wc = j >> 6, bj = (j >> 5) & 1;
                xpose_item(a.in[I_W_IN], INW, n0, a.in[I_ATTN_NORM], (bf16_t*)(ws + WS_WA), DM, tile * 256 + 128 * bj + 32 * wc, 64 * kb, scr, lane); }
            continue; } r -= J0;
        if (r < J1) { xpose_item(a.in[I_W_OUT], DM, 32 * (r % 64), nullptr, (bf16_t*)(ws + WS_WOUT), DM, 32 * (r % 64), 64 * (r / 64), scr, lane); continue; } r -= J1;
        if (r < J2) { xpose_item(a.in[I_XQ_W], XW, 32 * (r % 16), a.in[I_XATTN_NORM], (bf16_t*)(ws + WS_WXQ), DM, 32 * (r % 16), 64 * (r / 16), scr, lane); continue; } r -= J2;
        if (r < J2) { xpose_item(a.in[I_XK_W], XW, 32 * (r % 16), nullptr, (bf16_t*)(ws + WS_WXK), DM, 32 * (r % 16), 64 * (r / 16), scr, lane); continue; } r -= J2;
        if (r < J2) { xpose_item(a.in[I_XV_W], XW, 32 * (r % 16), nullptr, (bf16_t*)(ws + WS_WXV), DM, 32 * (r % 16), 64 * (r / 16), scr, lane); continue; } r -= J2;
        if (r < J5) { xpose_item(a.in[I_XO_W], DM, 32 * (r % 64), nullptr, (bf16_t*)(ws + WS_WXO), XW, 32 * (r % 64), 64 * (r / 64), scr, lane); continue; } r -= J5;
        if (r < J6) { const int kb = r / 352, pg = r % 352, p0 = 32 * pg, T = p0 >> 8, rem = p0 & 255, bj = rem >> 7, r2 = rem & 127;
            xpose_item(a.in[I_W_GU], 2 * DFF, bj * DFF + 128 * T + r2, a.in[I_FFN_NORM], (bf16_t*)(ws + WS_WGU), DM, p0, 64 * kb, scr, lane); continue; } r -= J6;
        { const int gi = r >> 4, which = (r >> 3) & 1, sub = r & 7, kb = sub >> 2, nb = sub & 3;
          xpose_item(a.in[which ? I_GX_W : I_GA_W] + (size_t)gi * 128 * 128, 128, 32 * nb, nullptr, (bf16_t*)(ws + WS_WGATE), 128, gi * 256 + which * 128 + 32 * nb, 64 * kb, scr, lane); }
    }
    float* rstd1 = (float*)(ws + WS_RSTD1);
    for (int grp = bid; grp < SEQ / 32; grp += G)
        for (int k = 0; k < 4; ++k) { const int m = grp * 32 + k * 8 + wave; const float rs = row_to_bf16(a.in[I_X] + (size_t)m * DM, (bf16_t*)(ws + WS_XB) + (size_t)m * DM, nullptr, false, lane); if (lane == 0) rstd1[m] = rs; }
    for (int m = gw; m < MEML; m += NGW) row_to_bf16(a.in[I_MEM] + (size_t)m * DM, (bf16_t*)(ws + WS_MEMN) + (size_t)m * DM, a.in[I_MEM_NORM], true, lane);
    for (int c = bid * NTHREADS + tid; c < RW; c += G * NTHREADS) ((float*)(ws + WS_SPL))[c] = 8.f * LOG2E * log1pf(expf(-a.in[I_RGL][c]));
}

__device__ __forceinline__ void wdn_convert(const Args& a, LAS unsigned char* lds, int nb, int rk, int tid) {
    const int wave = __builtin_amdgcn_readfirstlane(tid >> 6), lane = tid & 63;
    LAS float* scr = (LAS float*)(lds + wave * 16384);
    for (int r = rk * NWAVES + wave; r < 88 * 64; r += nb * NWAVES)
        xpose_item(a.in[I_W_DN], DM, 32 * (r % 64), nullptr, (bf16_t*)(a.ws + WS_WDN), DFF, 32 * (r % 64), 64 * (r / 64), scr, lane);
}
__device__ __forceinline__ void mk_norm_phase(const Args& a, int G, int bid, int tid) {
    const int wave = tid >> 6, lane = tid & 63;
    const float* raw = (const float*)(a.ws + WS_MKRAW); bf16_t* mkn = (bf16_t*)(a.ws + WS_MKN);
    for (int p = bid * NWAVES + wave; p < MEML * 4; p += G * NWAVES) {
        const float2 v = *(const float2*)(raw + (size_t)p * 128 + 2 * lane);
        const float r = rsqrtf(wave_sum(v.x * v.x + v.y * v.y) * (1.f / 128.f) + EPSF);
        const float2 g = *(const float2*)(a.in[I_XK_NORM] + 2 * lane);
        *(unsigned*)(mkn + (size_t)p * 128 + 2 * lane) = cvt_pk_bf16(v.x * r * g.x, v.y * r * g.y);
    }
}
__device__ __forceinline__ void mk_norm_cols(const Args& a, int pn, int tid) {
    const int wave = tid >> 6, lane = tid & 63;
    const float* raw = (const float*)(a.ws + WS_MKRAW); bf16_t* mkn = (bf16_t*)(a.ws + WS_MKN);
    for (int q = wave; q < MEML * 2; q += NWAVES) { const int row = q >> 1, head = pn * 2 + (q & 1); const size_t p = (size_t)row * 4 + head;
        const float2 v = *(const float2*)(raw + p * 128 + 2 * lane);
        const float r = rsqrtf(wave_sum(v.x * v.x + v.y * v.y) * (1.f / 128.f) + EPSF);
        const float2 g = *(const float2*)(a.in[I_XK_NORM] + 2 * lane);
        *(unsigned*)(mkn + p * 128 + 2 * lane) = cvt_pk_bf16(v.x * r * g.x, v.y * r * g.y); }
}
__device__ __forceinline__ void conv_phase(const Args& a, int G, int bid, int tid) {
    const bf16_t* xr = (const bf16_t*)(a.ws + WS_XR); bf16_t* xc = (bf16_t*)(a.ws + WS_XC);
    const int cg8 = (tid & 127) * 8, rsub = tid >> 7;
    float w[4][8], b[8];
#pragma unroll
    for (int j = 0; j < 4; ++j)
#pragma unroll
        for (int e = 0; e < 8; ++e) w[j][e] = a.in[I_CONV_W][j * RW + cg8 + e];
#pragma unroll
    for (int e = 0; e < 8; ++e) b[e] = a.in[I_CONV_B][cg8 + e];
    for (int it = bid; it < SEQ / 32; it += G) {
        const int t0 = it * 32 + rsub * 8;
        float win[3][8];
#pragma unroll
        for (int j = 0; j < 3; ++j) { const int t = t0 - 3 + j; u32x4 x = (u32x4){0u, 0u, 0u, 0u}; if (t >= 0) x = *(const u32x4*)(xr + (size_t)t * RW + cg8);
            win[j][0] = bf_lo(x.x); win[j][1] = bf_hi(x.x); win[j][2] = bf_lo(x.y); win[j][3] = bf_hi(x.y); win[j][4] = bf_lo(x.z); win[j][5] = bf_hi(x.z); win[j][6] = bf_lo(x.w); win[j][7] = bf_hi(x.w); }
#pragma unroll
        for (int i = 0; i < 8; ++i) { const int t = t0 + i; const u32x4 x = *(const u32x4*)(xr + (size_t)t * RW + cg8);
            float cur[8] = {bf_lo(x.x), bf_hi(x.x), bf_lo(x.y), bf_hi(x.y), bf_lo(x.z), bf_hi(x.z), bf_lo(x.w), bf_hi(x.w)};
            float o[8];
#pragma unroll
            for (int e = 0; e < 8; ++e) { o[e] = b[e] + w[0][e] * win[0][e] + w[1][e] * win[1][e] + w[2][e] * win[2][e] + w[3][e] * cur[e]; win[0][e] = win[1][e]; win[1][e] = win[2][e]; win[2][e] = cur[e]; }
            u32x4 ow; ow.x = cvt_pk_bf16(o[0], o[1]); ow.y = cvt_pk_bf16(o[2], o[3]); ow.z = cvt_pk_bf16(o[4], o[5]); ow.w = cvt_pk_bf16(o[6], o[7]);
            *(u32x4*)(xc + (size_t)t * RW + cg8) = ow; }
    }
}
#define MFMA32(a, b, c) __builtin_amdgcn_mfma_f32_32x32x16_bf16((a), (b), (c), 0, 0, 0)
__device__ __forceinline__ void rnn_front_phase(const Args& a, LAS unsigned char* lds, int G, int bid, int tid) {
    const int wid = __builtin_amdgcn_readfirstlane(tid >> 6), lane = tid & 63, r = lane & 31, h = lane >> 5;
    const bf16_t* XR = (const bf16_t*)(a.ws + WS_XR); const bf16_t* WG = (const bf16_t*)(a.ws + WS_WGATE);
    bf16_t* LAo = (bf16_t*)(a.ws + WS_LA); bf16_t* Uo = (bf16_t*)(a.ws + WS_U);
    float* As = (float*)(a.ws + WS_AS); float* He = (float*)(a.ws + WS_HEND);
    LAS float* LAb = (LAS float*)(lds + 49152); LAS float* Ub = (LAS float*)(lds + 81920);
    LAS float* GX = (LAS float*)(lds + 16384) + (wid & 3) * 2048;
    int gcur = -1; bf16x8 Bf[8];
    float ba = 0.f, bx = 0.f, sp = 0.f;
    u32x4 xq[5];
#define RNN_LOADX(itx) do { const int g_ = (itx) & 7, j_ = (itx) >> 3, co_ = tid & 15, rp_ = tid >> 4; \
        _Pragma("unroll") for (int q = 0; q < 5; ++q) { const int t = 64 * j_ + 2 * rp_ - 3 + q; xq[q] = (u32x4){0u, 0u, 0u, 0u}; if (t >= 0) xq[q] = *(const u32x4*)(XR + (size_t)t * RW + 128 * g_ + co_ * 8); } } while (0)
    if (bid < (SEQ / 64) * 8) RNN_LOADX(bid);
    for (int it = bid; it < (SEQ / 64) * 8; it += G) {
        const int g = it & 7, j = it >> 3, t0 = 64 * j, c0 = 128 * g;
        if (g != gcur) { gcur = g;
#pragma unroll
            for (int s = 0; s < 8; ++s) Bf[s] = *(const bf16x8*)(WG + (size_t)(g * 256 + 32 * wid + r) * 128 + 16 * s + 8 * h);
            const int cgh = c0 + (wid & 3) * 32 + r;
            ba = a.in[I_GA_B][cgh]; bx = a.in[I_GX_B][cgh]; sp = ((const float*)(a.ws + WS_SPL))[cgh]; }
        { const int co = tid & 15, rp = tid >> 4, ch = c0 + co * 8;
          float acc0[8], acc1[8];
#pragma unroll
          for (int e = 0; e < 8; ++e) { acc0[e] = a.in[I_CONV_B][ch + e]; acc1[e] = acc0[e]; }
#pragma unroll
          for (int jj = 0; jj < 4; ++jj) { const f32x4 w0 = *(const f32x4*)(a.in[I_CONV_W] + jj * RW + ch), w1 = *(const f32x4*)(a.in[I_CONV_W] + jj * RW + ch + 4);
              const u32x4 xa = xq[jj], xb = xq[jj + 1];
              const float va[8] = {bf_lo(xa.x), bf_hi(xa.x), bf_lo(xa.y), bf_hi(xa.y), bf_lo(xa.z), bf_hi(xa.z), bf_lo(xa.w), bf_hi(xa.w)};
              const float vb[8] = {bf_lo(xb.x), bf_hi(xb.x), bf_lo(xb.y), bf_hi(xb.y), bf_lo(xb.z), bf_hi(xb.z), bf_lo(xb.w), bf_hi(xb.w)};
#pragma unroll
              for (int e = 0; e < 8; ++e) { const float wv = e < 4 ? w0[e & 3] : w1[e & 3]; acc0[e] += wv * va[e]; acc1[e] += wv * vb[e]; } }
          const int r0 = 2 * rp, r1 = 2 * rp + 1;
          u32x4 o0, o1; o0.x = cvt_pk_bf16(acc0[0], acc0[1]); o0.y = cvt_pk_bf16(acc0[2], acc0[3]); o0.z = cvt_pk_bf16(acc0[4], acc0[5]); o0.w = cvt_pk_bf16(acc0[6], acc0[7]);
          o1.x = cvt_pk_bf16(acc1[0], acc1[1]); o1.y = cvt_pk_bf16(acc1[2], acc1[3]); o1.z = cvt_pk_bf16(acc1[4], acc1[5]); o1.w = cvt_pk_bf16(acc1[6], acc1[7]);
          *(LAS u32x4*)(lds + r0 * 256 + ((co ^ (r0 & 15)) << 4)) = o0;
          *(LAS u32x4*)(lds + r1 * 256 + ((co ^ (r1 & 15)) << 4)) = o1; }
        __syncthreads();
        f32x16 D[2];
#pragma unroll
        for (int mt = 0; mt < 2; ++mt) {
#pragma unroll
            for (int i = 0; i < 16; ++i) D[mt][i] = 0.f;
            const int row = 32 * mt + r;
#pragma unroll
            for (int s = 0; s < 8; ++s) { const bf16x8 xa = *(const LAS bf16x8*)(lds + row * 256 + (((2 * s + h) ^ (row & 15)) << 4)); D[mt] = MFMA32(xa, Bf[s], D[mt]); } }
        const int cl = (wid & 3) * 32 + r, cgl = c0 + cl;
        if (wid < 4) {
#pragma unroll
            for (int i = 0; i < 16; ++i) GX[1024 + i * 64 + lane] = D[1][i]; }
        else {
#pragma unroll
            for (int i = 0; i < 16; ++i) GX[i * 64 + lane] = D[0][i]; }
        __syncthreads();
        {
#define RNN_FIN(PA, PX, MT) do { _Pragma("unroll") for (int i = 0; i < 16; ++i) { const int row = 32 * (MT) + (i & 3) + 8 * (i >> 2) + 4 * h; \
                const float ga = __builtin_amdgcn_rcpf(1.f + __builtin_amdgcn_exp2f(-((PA) + ba) * LOG2E)); \
                const float gx = __builtin_amdgcn_rcpf(1.f + __builtin_amdgcn_exp2f(-((PX) + bx) * LOG2E)); \
                const float l2 = -ga * sp; \
                const float xl = 2.f * l2 * 0.6931471805599453f; \
                const float om = xl > -0.02f ? -(xl + xl * xl * (0.5f + xl * (1.f / 6.f))) : 1.f - __builtin_amdgcn_exp2f(2.f * l2); \
                const float xcv = bf_lo((unsigned)*(const LAS unsigned short*)(lds + row * 256 + (((cl >> 3) ^ (row & 15)) << 4) + (cl & 7) * 2)); \
                const float uv = xcv * gx * __builtin_amdgcn_sqrtf(om); \
                LAb[row * 128 + cl] = bf_lo(cvt_pk_bf16(l2, 0.f)); Ub[row * 128 + cl] = bf_lo(cvt_pk_bf16(uv, 0.f)); } } while (0)
          if (wid < 4) RNN_FIN(D[0][i], GX[i * 64 + lane], 0);
          else RNN_FIN(GX[1024 + i * 64 + lane], D[1][i], 1);
#undef RNN_FIN
        }
        __syncthreads();
        if (it + G < (SEQ / 64) * 8) RNN_LOADX(it + G);
#pragma unroll
        for (int q = 0; q < 2; ++q) { const int idx = tid + NTHREADS * q, row = idx >> 4, oc = idx & 15;
            const f32x4 l0 = *(const LAS f32x4*)(LAb + row * 128 + oc * 8), l1 = *(const LAS f32x4*)(LAb + row * 128 + oc * 8 + 4);
            const f32x4 u0 = *(const LAS f32x4*)(Ub + row * 128 + oc * 8), u1 = *(const LAS f32x4*)(Ub + row * 128 + oc * 8 + 4);
            *(u32x4*)(LAo + (size_t)(t0 + row) * RW + c0 + oc * 8) = pack8(l0, l1);
            *(u32x4*)(Uo + (size_t)(t0 + row) * RW + c0 + oc * 8) = pack8(u0, u1); }
        if (tid < 128) { float hh = 0.f, ssum = 0.f;
#pragma unroll 16
            for (int t = 0; t < 64; ++t) { const float l = LAb[t * 128 + tid], uu = Ub[t * 128 + tid]; ssum += l; hh = __builtin_amdgcn_exp2f(l) * hh + uu; }
            As[(size_t)j * RW + c0 + tid] = __builtin_amdgcn_exp2f(ssum); He[(size_t)j * RW + c0 + tid] = hh; }
    }
#undef RNN_LOADX
}
__device__ __forceinline__ void scanA_phase(const Args& a, int G, int bid, int tid) {
    const bf16_t* la = (const bf16_t*)(a.ws + WS_LA); const bf16_t* uu = (const bf16_t*)(a.ws + WS_U);
    float* As = (float*)(a.ws + WS_AS); float* He = (float*)(a.ws + WS_HEND);
    for (int ch = bid; ch < SEQ / 64; ch += G) {
        float h0 = 0.f, h1 = 0.f, s0 = 0.f, s1 = 0.f;
        const size_t base = (size_t)ch * 64 * RW + 2 * tid;
#pragma unroll 16
        for (int t = 0; t < 64; ++t) { const unsigned l = *(const unsigned*)(la + base + (size_t)t * RW), u = *(const unsigned*)(uu + base + (size_t)t * RW);
            const float l0 = bf_lo(l), l1 = bf_hi(l); s0 += l0; s1 += l1;
            h0 = __builtin_amdgcn_exp2f(l0) * h0 + bf_lo(u); h1 = __builtin_amdgcn_exp2f(l1) * h1 + bf_hi(u); }
        *(float2*)(As + (size_t)ch * RW + 2 * tid) = make_float2(s0, s1);
        *(float2*)(He + (size_t)ch * RW + 2 * tid) = make_float2(h0, h1);
    }
}
__device__ __forceinline__ float gelu_tanh(float y) {
    const float z = 0.7978845608028654f * (y + 0.044715f * y * y * y);
    const float e = __builtin_amdgcn_exp2f(2.f * LOG2E * z);
    const float th = 1.f - 2.f * __builtin_amdgcn_rcpf(1.f + e);
    return 0.5f * y * (1.f + th);
}
__device__ __forceinline__ void scanC_phase(const Args& a, LAS unsigned char* lds, int G, int bid, int tid) {
    const bf16_t* la = (const bf16_t*)(a.ws + WS_LA); const bf16_t* uu = (const bf16_t*)(a.ws + WS_U); const bf16_t* yr = (const bf16_t*)(a.ws + WS_YR);
    const float* As = (const float*)(a.ws + WS_AS); const float* He = (const float*)(a.ws + WS_HEND);
    bf16_t* mix = (bf16_t*)(a.ws + WS_MIX);
    const int wave = tid >> 6, lane = tid & 63;
    for (int ch = bid; ch < SEQ / 64; ch += G) {
        float h0 = 0.f, h1 = 0.f;
#pragma unroll 32
        for (int j = 0; j < ch; ++j) { const float2 s = *(const float2*)(As + (size_t)j * RW + 2 * tid), e = *(const float2*)(He + (size_t)j * RW + 2 * tid);
            h0 = s.x * h0 + e.x; h1 = s.y * h1 + e.y; }
        const size_t base = (size_t)ch * 64 * RW + 2 * tid;
#pragma unroll 16
        for (int t = 0; t < 64; ++t) { const unsigned l = *(const unsigned*)(la + base + (size_t)t * RW), u = *(const unsigned*)(uu + base + (size_t)t * RW), y = *(const unsigned*)(yr + base + (size_t)t * RW);
            h0 = __builtin_amdgcn_exp2f(bf_lo(l)) * h0 + bf_lo(u); h1 = __builtin_amdgcn_exp2f(bf_hi(l)) * h1 + bf_hi(u);
            *(LAS unsigned*)(lds + t * 2048 + tid * 4) = cvt_pk_bf16(h0 * gelu_tanh(bf_lo(y)), h1 * gelu_tanh(bf_hi(y))); }
        __syncthreads();
#pragma unroll
        for (int rr = 0; rr < 8; ++rr) { const int t = wave * 8 + rr;
            const u32x4 x0 = *(const LAS u32x4*)(lds + t * 2048 + lane * 16), x1 = *(const LAS u32x4*)(lds + t * 2048 + 1024 + lane * 16);
            float v[16] = {bf_lo(x0.x), bf_hi(x0.x), bf_lo(x0.y), bf_hi(x0.y), bf_lo(x0.z), bf_hi(x0.z), bf_lo(x0.w), bf_hi(x0.w),
                           bf_lo(x1.x), bf_hi(x1.x), bf_lo(x1.y), bf_hi(x1.y), bf_lo(x1.z), bf_hi(x1.z), bf_lo(x1.w), bf_hi(x1.w)};
            float ss = 0.f;
#pragma unroll
            for (int e = 0; e < 16; ++e) ss += v[e] * v[e];
            const float r = rsqrtf(wave_sum(ss) * (1.f / 1024.f) + EPSF);
            const float* gn = a.in[I_RNN_NORM];
#pragma unroll
            for (int hh = 0; hh < 2; ++hh) { const int c = hh * 512 + lane * 8; const f32x4 g0 = *(const f32x4*)(gn + c), g1 = *(const f32x4*)(gn + c + 4);
                u32x4 o; o.x = cvt_pk_bf16(v[8 * hh + 0] * r * g0[0], v[8 * hh + 1] * r * g0[1]); o.y = cvt_pk_bf16(v[8 * hh + 2] * r * g0[2], v[8 * hh + 3] * r * g0[3]);
                o.z = cvt_pk_bf16(v[8 * hh + 4] * r * g1[0], v[8 * hh + 5] * r * g1[1]); o.w = cvt_pk_bf16(v[8 * hh + 6] * r * g1[2], v[8 * hh + 7] * r * g1[3]);
                *(u32x4*)(mix + (size_t)(ch * 64 + t) * DM + AW + c) = o; } }
        __syncthreads();
    }
}
__device__ __forceinline__ int t5_bucket(int rel) {
    const int n = rel < 0 ? -rel : rel;
    int large = 8 + (int)(logf((float)(n < 1 ? 1 : n) / 8.0f) / 4.852030263919617f * 8.0f);
    large = large < 15 ? large : 15;
    return (rel > 0 ? 16 : 0) + (n < 8 ? n : large);
}
__device__ __forceinline__ void attn_phase(const Args& a, LAS unsigned char* lds, int G, int bid, int tid, bool scan_between) {
    const int wid = __builtin_amdgcn_readfirstlane(tid >> 6), lane = tid & 63, r = lane & 31, h = lane >> 5;
    const bf16_t* Q = (const bf16_t*)(a.ws + WS_Q); const bf16_t* Kb = (const bf16_t*)(a.ws + WS_K); const bf16_t* VT = (const bf16_t*)(a.ws + WS_VT);
    bf16_t* mix = (bf16_t*)(a.ws + WS_MIX);
    LAS float* tab = (LAS float*)(lds + 132096);
    float lam;
    { const float s1 = wave_sum(a.in[I_LQ1][lane] * a.in[I_LK1][lane]), s2 = wave_sum(a.in[I_LQ2][lane] * a.in[I_LK2][lane]); lam = __uint_as_float(__builtin_amdgcn_readfirstlane(__float_as_uint(expf(s1) - expf(s2) + 0.2f))); }
    const int rowk = (r & 0x13) | ((r & 4) << 1) | ((r & 8) >> 1);
    const int koff0 = rowk * 128 + ((h ^ ((rowk >> 1) & 7)) << 4), voff0 = r * 128 + ((h ^ ((r >> 1) & 7)) << 4);
#define KOFF(s) (koff0 ^ ((s) << 5))
#define VOFF(s) (16384 + (voff0 ^ ((s) << 5)))
    const unsigned ldsw = (unsigned)wid * 1024u;

    int tabhead = -1; bool scan_todo = scan_between;
    for (int ui = 0;; ++ui) {
        const int uidx = ui * G + bid; if (uidx >= 512) break;
        if (ui == 1 && scan_todo) { scan_todo = false; int ts_ = threadIdx.x; asm volatile("" : "+v"(ts_)); scanC_phase(a, lds, G, bid, ts_); }
        const int cc = uidx & 255, rnd = uidx >> 8, head = cc & 7, jj = cc >> 3;
        const int qb = rnd == 0 ? 63 - jj : jj;
        const int q0 = qb * 256, nst = 2 * qb + 2, cw = 4 * qb + (wid >> 1), qw = q0 + 32 * wid;
        int tu_ = threadIdx.x; asm volatile("" : "+v"(tu_));
        if (head != tabhead) { tabhead = head;
            for (int idx = tu_; idx < 1408; idx += NTHREADS) tab[idx] = a.in[I_RELB][t5_bucket(63 - idx) * 8 + head] * LOG2E; }
        const float farb = a.in[I_RELB][15 * 8 + head] * LOG2E;
        bf16x8 Qf[2][4];
#pragma unroll
        for (int mp = 0; mp < 2; ++mp)
#pragma unroll
            for (int s = 0; s < 4; ++s) Qf[mp][s] = *(const bf16x8*)(Q + (size_t)(qw + (tu_ & 31)) * AW + head * 128 + mp * 64 + 16 * s + 8 * ((tu_ >> 5) & 1));
        const bf16_t* kbase = Kb + head * 128; const bf16_t* vbase = VT + (size_t)head * 128 * SEQ;
#define ATT_GLDS(src, off) __builtin_amdgcn_global_load_lds((const unsigned*)(src), (LAS unsigned*)(lds + (off) + ldsw), 16, 0, 0)
#define ATT_DMA(p, b) do { int td_ = threadIdx.x; asm volatile("" : "+v"(td_));     \
            const int prow = td_ >> 3, pch = (td_ & 7) ^ ((prow >> 1) & 7); const unsigned gK = (unsigned)(prow * AW + pch * 8), gV = (unsigned)(prow * SEQ + pch * 8); \
            _Pragma("unroll") for (int sub = 0; sub < 2; ++sub) { const int k0_ = 128 * (p) + 64 * sub; const unsigned o_ = (unsigned)(b) * 65536u + (unsigned)sub * 32768u; \
            ATT_GLDS(kbase + (size_t)k0_ * AW + gK, o_); ATT_GLDS(kbase + (size_t)k0_ * AW + gK + 64, o_ + 8192u); \
            ATT_GLDS(vbase + gV + k0_, o_ + 16384u); ATT_GLDS(vbase + (size_t)64 * SEQ + gV + k0_, o_ + 24576u); } } while (0)
        ATT_DMA(0, 0);
        asm volatile("s_waitcnt vmcnt(0)" ::: "memory"); __syncthreads();
        f32x16 O1[4], O2[4];
#pragma unroll
        for (int dt = 0; dt < 4; ++dt)
#pragma unroll
            for (int i = 0; i < 16; ++i) { O1[dt][i] = 0.f; O2[dt][i] = 0.f; }
        f32x2_t sum1 = {0.f, 0.f}, sum2 = {0.f, 0.f};
        int pfar = (q0 - 1086 + 63) >> 7; pfar = pfar < 0 ? 0 : pfar;
        const float farscale = __builtin_amdgcn_exp2f(farb);
#define ATT_SB() __builtin_amdgcn_sched_barrier(0)
#define ATT_LDK(mo, s, kt) (*(const LAS bf16x8*)(buf + (mo) + KOFF(s) + (kt) * 4096))
#define ATT_LDV(c, dt) (*(const LAS bf16x8*)(buf + VOFF(c) + (dt) * 4096))
#define ATT_EXP(S, sum, pb) do { _Pragma("unroll") for (int s = 0; s < 2; ++s) { unsigned w[4]; \
            _Pragma("unroll") for (int pp = 0; pp < 4; ++pp) { const int i0 = 8 * s + 2 * pp; \
                const f32x2_t e = {__builtin_amdgcn_exp2f(S[i0]), __builtin_amdgcn_exp2f(S[i0 + 1])}; sum += e; w[pp] = cvt_pk_bf16(e[0], e[1]); } \
            pb[s] = __builtin_bit_cast(bf16x8, ((u32x4){w[0], w[1], w[2], w[3]})); } } while (0)
#define ATT_PV(va, s, d0) do { O1[d0] = MFMA32(va[0], pb1[s], O1[d0]); O2[d0] = MFMA32(va[0], pb2[s], O2[d0]); O1[d0 + 1] = MFMA32(va[1], pb1[s], O1[d0 + 1]); O2[d0 + 1] = MFMA32(va[1], pb2[s], O2[d0 + 1]); } while (0)
#define ATT_SUBTILE(INIT) do { bf16x8 kA[4], vA[2], pb1[2], pb2[2]; \
            _Pragma("unroll") for (int s = 0; s < 4; ++s) kA[s] = ATT_LDK(0, s, 0); \
            ATT_SB(); \
            _Pragma("unroll") for (int kt = 0; kt < 2; ++kt) { \
                f32x16 S; INIT(S); _Pragma("unroll") for (int s = 0; s < 4; ++s) S = MFMA32(kA[s], Qf[0][s], S); \
                ATT_SB(); \
                _Pragma("unroll") for (int s = 0; s < 4; ++s) kA[s] = ATT_LDK(8192, s, kt); \
                ATT_EXP(S, sum1, pb1); \
                ATT_SB(); \
                INIT(S); _Pragma("unroll") for (int s = 0; s < 4; ++s) S = MFMA32(kA[s], Qf[1][s], S); \
                ATT_SB(); \
                vA[0] = ATT_LDV(2 * kt, 0); vA[1] = ATT_LDV(2 * kt, 1); kA[0] = ATT_LDV(2 * kt, 2); kA[1] = ATT_LDV(2 * kt, 3); \
                ATT_EXP(S, sum2, pb2); \
                ATT_SB(); \
                ATT_PV(vA, 0, 0); \
                ATT_SB(); \
                vA[0] = ATT_LDV(2 * kt + 1, 0); vA[1] = ATT_LDV(2 * kt + 1, 1); ATT_PV(kA, 0, 2); \
                ATT_SB(); \
                kA[0] = ATT_LDV(2 * kt + 1, 2); kA[1] = ATT_LDV(2 * kt + 1, 3); ATT_PV(vA, 1, 0); \
                ATT_SB(); \
                ATT_PV(kA, 1, 2); \
                ATT_SB(); \
                if (kt == 0) { _Pragma("unroll") for (int s = 0; s < 4; ++s) kA[s] = ATT_LDK(0, s, 1); ATT_SB(); } } } while (0)
#define ATT_INIT_ZERO(S) do { _Pragma("unroll") for (int i = 0; i < 16; ++i) S[i] = 0.f; } while (0)
#define ATT_INIT_TAB(S) do { const int ib = ib0 - 32 * kt; _Pragma("unroll") for (int i = 0; i < 16; ++i) S[i] = tab[ib - (16 * (i >> 3) + (i & 7))]; } while (0)
        int p = 0;
        for (; p < pfar; ++p) {
            LAS unsigned char* const sbase = lds + (p & 1) * 65536;
#pragma unroll 1
            for (int sub = 0; sub < 2; ++sub) {
                if ((wid >= 4) == (sub == 0)) ATT_DMA(p + 1, (p + 1) & 1);
                LAS unsigned char* buf = sbase + sub * 32768;
                ATT_SUBTILE(ATT_INIT_ZERO);
            }
            asm volatile("s_waitcnt vmcnt(0)" ::: "memory"); __syncthreads();
        }
#pragma unroll
        for (int dt = 0; dt < 4; ++dt) { O1[dt] = O1[dt] * farscale; O2[dt] = O2[dt] * farscale; }
        sum1 = sum1 * farscale; sum2 = sum2 * farscale;
        for (; p < nst; ++p) {
            LAS unsigned char* const sbase = lds + (p & 1) * 65536;
#pragma unroll 1
            for (int sub = 0; sub < 2; ++sub) {
                if (p + 1 < nst && (wid >= 4) == (sub == 0)) ATT_DMA(p + 1, (p + 1) & 1);
                const int stl = 2 * p + sub;
                if (stl <= cw) {
                    LAS unsigned char* buf = sbase + sub * 32768;
                    const int k0 = 64 * stl;
                    const int ib0 = (qw + r) - k0 - 8 * h + 63;
                    ATT_SUBTILE(ATT_INIT_TAB);
                }
            }
            asm volatile("s_waitcnt vmcnt(0)" ::: "memory"); __syncthreads();
        }
#undef ATT_SUBTILE
        float t1 = sum1[0] + sum1[1], t2 = sum2[0] + sum2[1];
        t1 += __shfl_xor(t1, 32); t2 += __shfl_xor(t2, 32);
        const float i1 = 1.f / t1, i2 = lam / t2; float ss = 0.f;
#pragma unroll
        for (int dt = 0; dt < 4; ++dt)
#pragma unroll
            for (int i = 0; i < 16; ++i) { const float o = O1[dt][i] * i1 - O2[dt][i] * i2; O1[dt][i] = o; ss += o * o; }
        ss += __shfl_xor(ss, 32);
        const float rs = rsqrtf(ss * (1.f / 128.f) + EPSF) * 0.8f;
        int te_ = threadIdx.x; asm volatile("" : "+v"(te_)); const int re_ = te_ & 31, he_ = (te_ >> 5) & 1;
        bf16_t* orow = mix + (size_t)(qw + re_) * DM + head * 128;
#pragma unroll
        for (int dt = 0; dt < 4; ++dt)
#pragma unroll
            for (int g4 = 0; g4 < 4; ++g4) { const int d = 32 * dt + 8 * g4 + 4 * he_; const f32x4 gn = *(const f32x4*)(a.in[I_SUBLN] + d);
                u32x2 o; o.x = cvt_pk_bf16(O1[dt][4 * g4] * rs * gn[0], O1[dt][4 * g4 + 1] * rs * gn[1]); o.y = cvt_pk_bf16(O1[dt][4 * g4 + 2] * rs * gn[2], O1[dt][4 * g4 + 3] * rs * gn[3]);
                *(u32x2*)(orow + d) = o; }
    }
#undef ATT_DMA
#undef ATT_GLDS
    if (scan_todo) { int ts_ = threadIdx.x; asm volatile("" : "+v"(ts_)); scanC_phase(a, lds, G, bid, ts_); }
}

__device__ __forceinline__ void xattn_phase(const Args& a, LAS unsigned char* lds, int G, int bid, int tid) {
    const int wid = __builtin_amdgcn_readfirstlane(tid >> 6), lane = tid & 63, r = lane & 31, h = lane >> 5;
    const bf16_t* XQ = (const bf16_t*)(a.ws + WS_XQ); const float* MKR = (const float*)(a.ws + WS_MKRAW); const bf16_t* MVT = (const bf16_t*)(a.ws + WS_MVT);
    bf16_t* XO = (bf16_t*)(a.ws + WS_XOIN);
    const int rowk = (r & 0x13) | ((r & 4) << 1) | ((r & 8) >> 1);
    const float qsc = 0.08838834764831845f * LOG2E;
    for (int ub = bid; ub < 256; ub += G) {
        const int head = ub & 3, t = ((ub >> 2) * 8 + wid) * 32 + r;
#pragma unroll
        for (int i = 0; i < 8; ++i) { const int piece = wid * 8 + i;
            { const int row = piece * 2 + (lane >> 5), ch = (lane & 31) ^ (row & 15);
              __builtin_amdgcn_global_load_lds((const unsigned*)(MVT + (size_t)(head * 128 + row) * MEML + ch * 8), (LAS unsigned*)(lds + 65536 + piece * 1024), 16, 0, 0); } }
        { const float2 gk = *(const float2*)(a.in[I_XK_NORM] + 2 * lane);
#pragma unroll 1
          for (int i = 0; i < 4; ++i) { float2 kv[8];
#pragma unroll
            for (int j = 0; j < 8; ++j) kv[j] = *(const float2*)(MKR + (size_t)(wid * 32 + i * 8 + j) * XW + head * 128 + 2 * lane);
#pragma unroll
            for (int j = 0; j < 8; ++j) { const int row = wid * 32 + i * 8 + j;
                const float rk = rsqrtf(wave_sum(kv[j].x * kv[j].x + kv[j].y * kv[j].y) * (1.f / 128.f) + EPSF);
                *(LAS unsigned*)(lds + row * 256 + (((lane >> 2) ^ (row & 15)) << 4) + (lane & 3) * 4) = cvt_pk_bf16(kv[j].x * rk * gk.x, kv[j].y * rk * gk.y); } } }
        u32x4 qv[8]; float ss = 0.f;
#pragma unroll
        for (int s = 0; s < 8; ++s) { qv[s] = *(const u32x4*)(XQ + (size_t)t * XW + head * 128 + 16 * s + 8 * h);
            const float e0 = bf_lo(qv[s].x), e1 = bf_hi(qv[s].x), e2 = bf_lo(qv[s].y), e3 = bf_hi(qv[s].y), e4 = bf_lo(qv[s].z), e5 = bf_hi(qv[s].z), e6 = bf_lo(qv[s].w), e7 = bf_hi(qv[s].w);
            ss += (e0 * e0 + e1 * e1) + (e2 * e2 + e3 * e3) + (e4 * e4 + e5 * e5) + (e6 * e6 + e7 * e7); }
        ss += __shfl_xor(ss, 32);
        const float rq = rsqrtf(ss * (1.f / 128.f) + EPSF) * qsc;
#pragma unroll
        for (int s = 0; s < 8; ++s) { const f32x4 g0 = *(const f32x4*)(a.in[I_XQ_NORM] + 16 * s + 8 * h), g1 = *(const f32x4*)(a.in[I_XQ_NORM] + 16 * s + 8 * h + 4);
            u32x4 w; w.x = cvt_pk_bf16(bf_lo(qv[s].x) * rq * g0[0], bf_hi(qv[s].x) * rq * g0[1]); w.y = cvt_pk_bf16(bf_lo(qv[s].y) * rq * g0[2], bf_hi(qv[s].y) * rq * g0[3]);
            w.z = cvt_pk_bf16(bf_lo(qv[s].z) * rq * g1[0], bf_hi(qv[s].z) * rq * g1[1]); w.w = cvt_pk_bf16(bf_lo(qv[s].w) * rq * g1[2], bf_hi(qv[s].w) * rq * g1[3]); qv[s] = w; }
        asm volatile("s_waitcnt vmcnt(0)" ::: "memory"); __syncthreads();
        f32x16 O[4];
#pragma unroll
        for (int dt = 0; dt < 4; ++dt)
#pragma unroll
            for (int i = 0; i < 16; ++i) O[dt][i] = 0.f;
        f32x2_t sum = {0.f, 0.f};
#pragma unroll 2
        for (int kt = 0; kt < 8; ++kt) {
            f32x16 sacc;
#pragma unroll
            for (int i = 0; i < 16; ++i) sacc[i] = 0.f;
            const int krow = 32 * kt + rowk;
#pragma unroll
            for (int s = 0; s < 8; ++s) { const bf16x8 ka = *(const LAS bf16x8*)(lds + krow * 256 + (((2 * s + h) ^ (krow & 15)) << 4)); sacc = MFMA32(ka, __builtin_bit_cast(bf16x8, qv[s]), sacc); }
            u32x4 pb[2];
#pragma unroll
            for (int s = 0; s < 2; ++s) { unsigned w[4];
#pragma unroll
                for (int p = 0; p < 4; ++p) { const f32x2_t e = {__builtin_amdgcn_exp2f(sacc[8 * s + 2 * p]), __builtin_amdgcn_exp2f(sacc[8 * s + 2 * p + 1])}; sum += e; w[p] = cvt_pk_bf16(e[0], e[1]); }
                pb[s] = (u32x4){w[0], w[1], w[2], w[3]}; }
#pragma unroll
            for (int dt = 0; dt < 4; ++dt)
#pragma unroll
                for (int s = 0; s < 2; ++s) { const int vrow = 32 * dt + r, c = 4 * kt + 2 * s + h;
                    const bf16x8 va = *(const LAS bf16x8*)(lds + 65536 + vrow * 512 + ((c ^ (vrow & 15)) << 4));
                    O[dt] = MFMA32(va, __builtin_bit_cast(bf16x8, pb[s]), O[dt]); }
        }
        float tot = sum[0] + sum[1]; tot += __shfl_xor(tot, 32);
        const float inv = 1.f / tot;
        bf16_t* orow = XO + (size_t)t * XW + head * 128;
#pragma unroll
        for (int dt = 0; dt < 4; ++dt)
#pragma unroll
            for (int g4 = 0; g4 < 4; ++g4) { u32x2 o; o.x = cvt_pk_bf16(O[dt][4 * g4] * inv, O[dt][4 * g4 + 1] * inv); o.y = cvt_pk_bf16(O[dt][4 * g4 + 2] * inv, O[dt][4 * g4 + 3] * inv);
                *(u32x2*)(orow + 32 * dt + 8 * g4 + 4 * h) = o; }
        __syncthreads();
    }
}

#define XB_TMO      128
#define XB_XCNT(j)  (256  + 64 * (j))
#define XB_XSUB(j)  (1280 + 64 * (j))
#define XB_XGEN(j)  (2304 + 64 * (j))
#define XB_TOP      3328
#define XB_TOPGEN   3392
#define XCD_BAR_WORDS 3456
#define XB_SPIN_CAP (1u << 18)

__device__ __forceinline__ unsigned xb_ld(unsigned* p)              { return __hip_atomic_load(p, __ATOMIC_RELAXED, __HIP_MEMORY_SCOPE_AGENT); }
__device__ __forceinline__ unsigned xb_add(unsigned* p, unsigned v) { return __hip_atomic_fetch_add(p, v, __ATOMIC_RELAXED, __HIP_MEMORY_SCOPE_AGENT); }
__device__ __forceinline__ unsigned xb_xcc_id() { return (unsigned)__builtin_amdgcn_s_getreg((3 << 11) | 20) & 0xFu; }
#define XB_SPIN(cond, bar) do { unsigned _sp = 0; while (cond) { __builtin_amdgcn_s_sleep(1); \
    if ((++_sp & 255u) == 0u) { if (xb_ld(&(bar)[XB_TMO])) break; if (_sp > XB_SPIN_CAP) { atomicAdd(&(bar)[XB_TMO], 1u); break; } } } } while (0)

struct XcdBarrier {
    unsigned* bar; unsigned x;
    volatile LAS unsigned* st;
};

__device__ __forceinline__ XcdBarrier xcd_barrier_post(unsigned* bar, volatile LAS unsigned* st) {
    XcdBarrier b; b.bar = bar; b.x = xb_xcc_id(); b.st = st;
    if (threadIdx.x == 0) (void)xb_add(&bar[XB_XCNT(b.x)], 1u);
    return b;
}
__device__ __forceinline__ void xcd_barrier_complete(unsigned* bar, unsigned x, unsigned& nloc, unsigned& nx) {
    const unsigned G = gridDim.x * gridDim.y * gridDim.z;
    unsigned sum, cnt, mine, sp = 0u;
    for (;;) {
        sum = 0u; cnt = 0u; mine = 0u;
#pragma unroll
        for (unsigned j = 0; j < 16; ++j) { const unsigned c = xb_ld(&bar[XB_XCNT(j)]); sum += c; cnt += (c > 0u) ? 1u : 0u; mine = (j == x) ? c : mine; }
        if (sum == G) break;
        __builtin_amdgcn_s_sleep(1);
        if ((++sp & 255u) == 0u) { if (xb_ld(&bar[XB_TMO])) break; if (sp > XB_SPIN_CAP) { atomicAdd(&bar[XB_TMO], 1u); break; } }
    }
    nloc = mine > 0u ? mine : 1u; nx = cnt > 0u ? cnt : 1u;
}

__device__ __forceinline__ void xcd_barrier(const XcdBarrier& b) {
    asm volatile("s_waitcnt vmcnt(0)" ::: "memory");
    __syncthreads();
    if (threadIdx.x == 0) {
        unsigned* bar = b.bar;
        __builtin_amdgcn_s_waitcnt(0);
        unsigned nloc = b.st[0], nx = b.st[1];
        if (nloc == 0u) { xcd_barrier_complete(bar, b.x, nloc, nx); b.st[0] = nloc; b.st[1] = nx; }
        const unsigned old = xb_add(&bar[XB_XSUB(b.x)], 1u);
        const unsigned gen = old / nloc;
        if (old + 1u == (gen + 1u) * nloc) {
            __builtin_amdgcn_fence(__ATOMIC_RELEASE, "agent");
            asm volatile("s_waitcnt vmcnt(0)" ::: "memory");
            const unsigned og = xb_add(&bar[XB_TOP], 1u);
            const unsigned tg = og / nx;
            if (og + 1u == (tg + 1u) * nx) xb_add(&bar[XB_TOPGEN], 1u);
            else XB_SPIN(xb_ld(&bar[XB_TOPGEN]) == tg, bar);
            __builtin_amdgcn_fence(__ATOMIC_ACQUIRE, "agent");
            xb_add(&bar[XB_XGEN(b.x)], 1u);
            asm volatile("s_waitcnt vmcnt(0)" ::: "memory");
        } else {
            XB_SPIN(xb_ld(&bar[XB_XGEN(b.x)]) == gen, bar);
            __builtin_amdgcn_fence(__ATOMIC_ACQUIRE, "agent");
            asm volatile("s_waitcnt vmcnt(0)" ::: "memory");
        }
    }
    __syncthreads();
}

#ifndef DBG
#define DBG 0
#endif
__device__ __forceinline__ void dbg_dump(const bf16_t* src, float* out, size_t n, int G, int bid, int tid) {
    for (size_t i = (size_t)bid * NTHREADS + tid; i < n; i += (size_t)G * NTHREADS) out[i] = bf_lo((unsigned)src[i]);
}
#define DBG_AT(k, ...) if constexpr (DBG == (k)) { __VA_ARGS__; return; }
__global__ void __launch_bounds__(NTHREADS, 2) fwd_megakernel(Args a) {
    extern __shared__ __attribute__((aligned(16))) unsigned char lds_raw[];
    LAS unsigned char* lds = (LAS unsigned char*)lds_raw;
    cg::grid_group grid = cg::this_grid();
#ifndef PROBE
#define PROBE -1
#endif
#define REP(k) for (int rep_ = 0; rep_ < ((PROBE == (k)) ? 2 : 1); ++rep_)
    volatile LAS unsigned* misc = (volatile LAS unsigned*)(lds + 131072 + 256);
    if (threadIdx.x < 4) misc[threadIdx.x] = 0u;
    __syncthreads();
    XcdBarrier xbar = xcd_barrier_post((unsigned*)(a.ws + WS_BAR), misc);
#define GRID_SYNC() xcd_barrier(xbar)
    const int tid = threadIdx.x, bid = blockIdx.x, G = gridDim.x;
    unsigned char* ws = a.ws;
    typedef bf16_t* BP; typedef float* FP;

#ifndef PHMASK
#define PHMASK 0xFFFFF
#endif
#define PH(k) if constexpr ((PHMASK >> (k)) & 1)
    REP(0) PH(0) { int t_ = tid; asm volatile("" : "+v"(t_)); p0_prologue(a, lds, G, bid, t_); }
    GRID_SYNC();
    if (G == 0x7fffffff) grid.sync();
    REP(1) {
        PH(1) { Gemm g{(BP)(ws + WS_XB), (BP)(ws + WS_WA), SEQ, 4096, DM, DM, DM, 0}; StaticOrder S; S.init(SEQ, 4096, G, bid);
          EpiIn E{(FP)(ws + WS_RSTD1), (BP)(ws + WS_Q), (BP)(ws + WS_K), (BP)(ws + WS_XR), (BP)(ws + WS_YR), a.in[I_QN], a.in[I_KN], 0.125f * LOG2E};
          gemm_phase<EpiIn, StaticOrder, true, true>(lds, g, S, E); }
        __syncthreads();
        PH(2) { Gemm g{(BP)(ws + WS_WV), (BP)(ws + WS_XB), 1024, SEQ, DM, DM, DM, 0}; StaticOrder S; S.init(1024, SEQ, G, bid);
          EpiVT E{(FP)(ws + WS_RSTD1), (BP)(ws + WS_VT)};
          gemm_phase<EpiVT, StaticOrder, true, true>(lds, g, S, E); }
    }
    GRID_SYNC();
    DBG_AT(1, dbg_dump((BP)(ws + WS_Q), a.out, (size_t)SEQ * 2048, G, bid, tid))
    DBG_AT(2, dbg_dump((BP)(ws + WS_VT), a.out, (size_t)SEQ * 2048, G, bid, tid))
    REP(2) { int t_ = tid; asm volatile("" : "+v"(t_)); rnn_front_phase(a, lds, G, bid, t_); }
    GRID_SYNC();
    DBG_AT(3, dbg_dump((BP)(ws + WS_LA), a.out, (size_t)SEQ * 2048, G, bid, tid))
    { const bool sbw = ((bid >> 3) & 1) != 0;
      if (!sbw) { int t_ = tid; asm volatile("" : "+v"(t_)); scanC_phase(a, lds, G, bid, t_); }
      { int t_ = tid; asm volatile("" : "+v"(t_)); attn_phase(a, lds, G, bid, t_, sbw); } }
    GRID_SYNC();
    DBG_AT(5, dbg_dump((BP)(ws + WS_MIX), a.out, (size_t)SEQ * 2048, G, bid, tid))
    DBG_AT(7, for (size_t i = (size_t)bid * NTHREADS + tid; i < (size_t)SEQ * 2048; i += (size_t)G * NTHREADS) a.out[i] = (i & 2047) < 1024 ? bf_lo((unsigned)((BP)(ws + WS_MIX))[i]) : 0.f)
    DBG_AT(8, for (size_t i = (size_t)bid * NTHREADS + tid; i < (size_t)SEQ * 2048; i += (size_t)G * NTHREADS) a.out[i] = (i & 2047) >= 1024 ? bf_lo((unsigned)((BP)(ws + WS_MIX))[i]) : 0.f)
    REP(6) PH(11) { Gemm g{(BP)(ws + WS_MIX), (BP)(ws + WS_WOUT), SEQ, DM, DM, DM, DM, 0}; StaticOrder S; S.init(SEQ, DM, G, bid);
      EpiRes<true, true> E{(const void*)(ws + WS_XB), (void*)(ws + WS_XB), (FP)(ws + WS_SSQP2)};
      gemm_phase<EpiRes<true, true>, StaticOrder, true, true>(lds, g, S, E); }
    GRID_SYNC();
    REP(7) PH(12) { Gemm g{(BP)(ws + WS_XB), (BP)(ws + WS_WXQ), SEQ, XW, DM, DM, DM, 0}; StaticOrder S; S.init(SEQ, XW, G, bid);
      EpiPlain<false> E{(void*)(ws + WS_XQ), XW, (FP)(ws + WS_SSQP2)};
      gemm_phase<EpiPlain<false>, StaticOrder, true, true>(lds, g, S, E); }
    __syncthreads();
    { Gemm g{(BP)(ws + WS_MEMN), (BP)(ws + WS_WXK), MEML, XW, DM, DM, DM, 0}; StaticOrder S; S.init(MEML, XW, G, (bid + 128) % G);
      EpiPlain<true> E{(void*)(ws + WS_MKRAW), XW, nullptr};
      gemm_phase<EpiPlain<true>, StaticOrder, true, true>(lds, g, S, E); }
    __syncthreads();
    { Gemm g{(BP)(ws + WS_WXV), (BP)(ws + WS_MEMN), XW, MEML, DM, DM, DM, 0}; StaticOrder S; S.init(XW, MEML, G, (bid + 126) % G);
      EpiPlain<false> E{(void*)(ws + WS_MVT), MEML, nullptr};
      gemm_phase<EpiPlain<false>, StaticOrder, true, true>(lds, g, S, E); }
    __syncthreads();
    { const int first_idle = (SEQ / 256) * (XW / 256) + 4;
      if (G > first_idle + 16) { if (bid >= first_idle) { int t_ = tid; asm volatile("" : "+v"(t_)); wdn_convert(a, lds, G - first_idle, bid - first_idle, t_); } }
      else { int t_ = tid; asm volatile("" : "+v"(t_)); wdn_convert(a, lds, G, bid, t_); } }
    GRID_SYNC();
    REP(8) PH(13) { int t_ = tid; asm volatile("" : "+v"(t_)); xattn_phase(a, lds, G, bid, t_); }
    GRID_SYNC();
    PH(14) { Gemm g{(BP)(ws + WS_XOIN), (BP)(ws + WS_WXO), SEQ, DM, XW, XW, XW, 0}; StaticOrder S; S.init(SEQ, DM, G, bid);
      EpiRes<true, true> E{(const void*)(ws + WS_XB), (void*)(ws + WS_XB), (FP)(ws + WS_SSQP3)};
      gemm_phase<EpiRes<true, true>, StaticOrder, true, true>(lds, g, S, E); }
    GRID_SYNC();
    REP(10) PH(15) { Gemm g{(BP)(ws + WS_XB), (BP)(ws + WS_WGU), SEQ, 2 * DFF, DM, DM, DM, 0}; StaticOrder S; S.init(SEQ, 2 * DFF, G, bid);
      EpiGU E{(FP)(ws + WS_SSQP3), (BP)(ws + WS_HID)};
      gemm_phase<EpiGU, StaticOrder, true, true>(lds, g, S, E); }
    GRID_SYNC();
    PH(16) { Gemm g{(BP)(ws + WS_HID), (BP)(ws + WS_WDN), SEQ, DM, DFF, DFF, DFF, 0}; StaticOrder S; S.init(SEQ, DM, G, bid);
      EpiRes<true, false> E{(const void*)(ws + WS_XB), (void*)a.out, nullptr};
      gemm_phase<EpiRes<true, false>, StaticOrder, true, true>(lds, g, S, E); }
}

extern "C" void kernel_launch(void* const* d_in, const int* in_sizes, int n_in, void* d_out, int out_size, void* d_ws, size_t ws_size, hipStream_t stream) {
    static int grid = 0;
    if (grid == 0) {
        if (n_in != 32 || ws_size < WS_END) { fprintf(stderr, "kernel_launch: unexpected problem (n_in %d, ws %zu)\n", n_in, ws_size); grid = -1; return; }
        int dev = 0, cus = 0, per_cu = 0;
        hipGetDevice(&dev); hipDeviceGetAttribute(&cus, hipDeviceAttributeMultiprocessorCount, dev);
        if (hipFuncSetAttribute((const void*)fwd_megakernel, hipFuncAttributeMaxDynamicSharedMemorySize, LDS_BYTES) != hipSuccess) { fprintf(stderr, "kernel_launch: hipFuncSetAttribute failed\n"); grid = -1; return; }
        hipOccupancyMaxActiveBlocksPerMultiprocessor(&per_cu, (const void*)fwd_megakernel, NTHREADS, LDS_BYTES);
        if (per_cu < 1) { fprintf(stderr, "kernel_launch: occupancy query says %d blocks per CU\n", per_cu); per_cu = 1; }
        (void)hipGetLastError();
        grid = cus * per_cu;
    }
    if (grid < 0) return;
    if (hipMemsetAsync((char*)d_ws + WS_BAR, 0, 16 * KiB, stream) != hipSuccess) { fprintf(stderr, "kernel_launch: hipMemsetAsync failed\n"); return; }
    Args a{};
    for (int i = 0; i < 32; ++i) a.in[i] = (const float*)d_in[i];
    a.out = (float*)d_out; a.ws = (unsigned char*)d_ws;
    void* args[] = {&a};
    hipError_t e = hipLaunchCooperativeKernel((const void*)fwd_megakernel, dim3(grid), dim3(NTHREADS), args, LDS_BYTES, stream);
    if (e != hipSuccess) fprintf(stderr, "cooperative launch failed: %s (grid %d)\n", hipGetErrorString(e), grid);
}
```

```cpp
#include <hip/hip_runtime.h>
#include <hip/hip_cooperative_groups.h>
#include <cstdio>
#include <cstdint>
namespace cg = cooperative_groups;
#define LAS __attribute__((address_space(3)))
namespace pg8 {
#define PG8_LAS __attribute__((address_space(3)))
typedef unsigned short bf16_t;
typedef short bf16x8 __attribute__((ext_vector_type(8)));
typedef float f32x4 __attribute__((ext_vector_type(4)));
typedef unsigned u32x4 __attribute__((ext_vector_type(4)));
constexpr int BM = 256, BK = 64, HALF = 128, HTB = HALF * BK * 2  , STAGE_BYTES = 8 * HTB, NXCD = 8, WGM = 8;

__host__ __device__ __forceinline__ int lds_byte(int r, int c) { const int st = (r >> 4) * 2 + (c >> 5), rr = r & 15, cc = c & 31, ob = rr * 64 + cc * 2; return st * 1024 + (ob ^ (((ob >> 9) & 1) << 5)); }
__host__ __device__ __forceinline__ void stage_rc(int b, int& R, int& C) { const int st = b / 1024, sb = b % 1024, swz = sb ^ (((sb >> 9) & 1) << 5); R = (st >> 1) * 16 + swz / 64; C = (st & 1) * 32 + (swz % 64) / 2; }
__host__ __device__ __forceinline__ int perm32(int rho) { const int n = rho >> 4, i = rho & 15; return 8 * (i >> 2) + 4 * n + (i & 3); }

struct Unit { int pm, pn; };
struct Gemm { const bf16_t* A; const bf16_t* Bt; int M, N, K, lda, ldb; long apn; };

struct StaticOrder {
    int nM, nN, nwg, G, c;
    __host__ __device__ void init(int M, int N, int G_, int c_) { nM = M / BM; nN = N / BM; nwg = nM * nN; G = G_; c = c_; }
    __host__ __device__ bool next(int i, Unit& u) const {
        const long L = (long)i * G + c; if (L >= nwg) return false;
        int wgid = (int)L; { const int q = nwg / NXCD, r = nwg % NXCD, xcd = wgid % NXCD, off = wgid / NXCD; wgid = (xcd < r ? xcd * (q + 1) : r * (q + 1) + (xcd - r) * q) + off; }
        const int nig = WGM * nN, gid = wgid / nig, fm = gid * WGM, gsz = (nM - fm) < WGM ? (nM - fm) : WGM;
        u.pm = fm + ((wgid % nig) % gsz); u.pn = (wgid % nig) / gsz; return true;
    }
    __device__ __forceinline__ void a_ready(const Unit&) const {}
    __device__ __forceinline__ void done(const Unit&) const {}
};

typedef unsigned u32x2 __attribute__((ext_vector_type(2)));
typedef float f32x16 __attribute__((ext_vector_type(16)));
typedef __bf16 bf16x2_t __attribute__((ext_vector_type(2)));
typedef float f32x2_t __attribute__((ext_vector_type(2)));
__device__ __forceinline__ unsigned cvt_pk_bf16(float lo, float hi) { const f32x2_t v = {lo, hi}; const bf16x2_t b = __builtin_convertvector(v, bf16x2_t); return __builtin_bit_cast(unsigned, b); }
__device__ __forceinline__ u32x4 pack8(const f32x4 a, const f32x4 b) { u32x4 w; w.x = cvt_pk_bf16(a[0], a[1]); w.y = cvt_pk_bf16(a[2], a[3]); w.z = cvt_pk_bf16(b[0], b[1]); w.w = cvt_pk_bf16(b[2], b[3]); return w; }
__device__ __forceinline__ float bf_lo(unsigned w) { return __uint_as_float(w << 16); }
__device__ __forceinline__ float bf_hi(unsigned w) { return __uint_as_float(w & 0xffff0000u); }
constexpr float EPSF = 1e-6f, LOG2E = 1.4426950408889634f;

struct EpiIn {
    static constexpr bool PERM = true, AFTER_DRAIN = false;
    const float* rstd; bf16_t *q, *k, *xr, *yr; const float *qg, *kg; float qscale;
    __device__ __forceinline__ void operator()(const f32x4 (&acc)[2][2][4][2], const Unit& u, int wr, int wc, int fr, int fq) const {
        const int region = u.pn >> 2;
        const int lc0 = (u.pn & 3) * 256 + wc * 64 + fq * 8;
        bf16_t* dst = q + (size_t)region * (16u << 20) + (region >= 2 ? (size_t)(16u << 20) : (size_t)0);
        const bool nrm = region < 2;
        f32x4 g[2][2];
#pragma unroll
        for (int bj = 0; bj < 2; ++bj)
#pragma unroll
            for (int n = 0; n < 2; ++n) g[bj][n] = (f32x4){1.f, 1.f, 1.f, 1.f};
        if (nrm) { const float* gp = region == 0 ? qg : kg; const float sc = region == 0 ? qscale : 1.f;
#pragma unroll
            for (int bj = 0; bj < 2; ++bj)
#pragma unroll
                for (int n = 0; n < 2; ++n) g[bj][n] = *(const f32x4*)(gp + 32 * bj + fq * 8 + 4 * n) * sc; }
#pragma unroll
        for (int ai = 0; ai < 2; ++ai)
#pragma unroll
            for (int m = 0; m < 4; ++m) {
                const int row = u.pm * BM + ai * HALF + wr * 64 + m * 16 + fr; const float rs = rstd[row];
                f32x4 v[2][2]; float ss = 0.f;
#pragma unroll
                for (int bj = 0; bj < 2; ++bj)
#pragma unroll
                    for (int n = 0; n < 2; ++n) { v[bj][n] = acc[ai][bj][m][n] * rs; const f32x4 t = v[bj][n] * v[bj][n]; ss += (t[0] + t[1]) + (t[2] + t[3]); }
                float r = 1.f;
                if (nrm) { ss += __shfl_xor(ss, 16); ss += __shfl_xor(ss, 32); r = rsqrtf(ss * (1.f / 64.f) + EPSF); }
#pragma unroll
                for (int bj = 0; bj < 2; ++bj) { const u32x4 w = pack8(v[bj][0] * g[bj][0] * r, v[bj][1] * g[bj][1] * r);
                    *(u32x4*)(dst + (size_t)row * 1024 + lc0 + 32 * bj) = w; }
            }
    }
};
struct EpiVT {
    static constexpr bool PERM = true, AFTER_DRAIN = false;
    const float* rstd; bf16_t* vT;
    __device__ __forceinline__ void operator()(const f32x4 (&acc)[2][2][4][2], const Unit& u, int wr, int wc, int fr, int fq) const {
        f32x4 rs[2][2];
#pragma unroll
        for (int bj = 0; bj < 2; ++bj)
#pragma unroll
            for (int n = 0; n < 2; ++n) rs[bj][n] = *(const f32x4*)(rstd + u.pn * BM + bj * HALF + wc * 32 + fq * 8 + 4 * n);
#pragma unroll
        for (int ai = 0; ai < 2; ++ai)
#pragma unroll
            for (int m = 0; m < 4; ++m) { const int row = u.pm * BM + ai * HALF + wr * 64 + m * 16 + fr;
#pragma unroll
                for (int bj = 0; bj < 2; ++bj) *(u32x4*)(vT + (size_t)row * 16384 + u.pn * BM + bj * HALF + wc * 32 + fq * 8) = pack8(acc[ai][bj][m][0] * rs[bj][0], acc[ai][bj][m][1] * rs[bj][1]); }
    }
};
__device__ __forceinline__ float row_rstd32(const float* ssqp, int row, int fq) {
    const f32x4 a = *(const f32x4*)(ssqp + ((size_t)(2 * fq) * 16384 + row) * 4), b = *(const f32x4*)(ssqp + ((size_t)(2 * fq + 1) * 16384 + row) * 4);
    float s = ((a[0] + a[1]) + (a[2] + a[3])) + ((b[0] + b[1]) + (b[2] + b[3]));
    s += __shfl_xor(s, 16); s += __shfl_xor(s, 32);
    return rsqrtf(s * (1.f / 2048.f) + EPSF);
}
template <bool F32OUT> struct EpiPlain {
    static constexpr bool PERM = true, AFTER_DRAIN = false;
    void* out; int ldc; const float* ssq;
    __device__ __forceinline__ void operator()(const f32x4 (&acc)[2][2][4][2], const Unit& u, int wr, int wc, int fr, int fq) const {
#pragma unroll
        for (int ai = 0; ai < 2; ++ai)
#pragma unroll
            for (int m = 0; m < 4; ++m) { const int row = u.pm * BM + ai * HALF + wr * 64 + m * 16 + fr;
                const float rs = ssq ? row_rstd32(ssq, row, fq) : 1.f;
#pragma unroll
                for (int bj = 0; bj < 2; ++bj) { const size_t off = (size_t)row * ldc + u.pn * BM + bj * HALF + wc * 32 + fq * 8;
                    if (F32OUT) { *(f32x4*)((float*)out + off) = acc[ai][bj][m][0] * rs; *(f32x4*)((float*)out + off + 4) = acc[ai][bj][m][1] * rs; }
                    else *(u32x4*)((bf16_t*)out + off) = pack8(acc[ai][bj][m][0] * rs, acc[ai][bj][m][1] * rs); } }
    }
};
template <bool BASE_BF16, bool OUT_BF16> struct EpiRes {
    static constexpr bool PERM = true, AFTER_DRAIN = false;
    const void* base; void* out; float* ssq;
    __device__ __forceinline__ void operator()(const f32x4 (&acc)[2][2][4][2], const Unit& u, int wr, int wc, int fr, int fq) const {
#pragma unroll
        for (int ai = 0; ai < 2; ++ai)
#pragma unroll
            for (int m = 0; m < 4; ++m) { const int row = u.pm * BM + ai * HALF + wr * 64 + m * 16 + fr; float ss = 0.f;
#pragma unroll
                for (int bj = 0; bj < 2; ++bj) { const size_t off = (size_t)row * 2048 + u.pn * BM + bj * HALF + wc * 32 + fq * 8;
                    f32x4 b0, b1;
                    if (BASE_BF16) { const u32x4 w = *(const u32x4*)((const bf16_t*)base + off); b0 = (f32x4){bf_lo(w.x), bf_hi(w.x), bf_lo(w.y), bf_hi(w.y)}; b1 = (f32x4){bf_lo(w.z), bf_hi(w.z), bf_lo(w.w), bf_hi(w.w)}; }
                    else { b0 = *(const f32x4*)((const float*)base + off); b1 = *(const f32x4*)((const float*)base + off + 4); }
                    const f32x4 v0 = b0 + acc[ai][bj][m][0], v1 = b1 + acc[ai][bj][m][1];
                    if (OUT_BF16) *(u32x4*)((bf16_t*)out + off) = pack8(v0, v1);
                    else { *(f32x4*)((float*)out + off) = v0; *(f32x4*)((float*)out + off + 4) = v1; }
                    const f32x4 t0 = v0 * v0, t1 = v1 * v1; ss += ((t0[0] + t0[1]) + (t0[2] + t0[3])) + ((t1[0] + t1[1]) + (t1[2] + t1[3])); }
                if (ssq) { ss += __shfl_xor(ss, 16); ss += __shfl_xor(ss, 32); if (fq == 0) ssq[((size_t)u.pn * 16384 + row) * 4 + wc] = ss; }
            }
    }
};
struct EpiGU {
    static constexpr bool PERM = true, AFTER_DRAIN = false;
    const float* ssq; bf16_t* hid;
    __device__ __forceinline__ void operator()(const f32x4 (&acc)[2][2][4][2], const Unit& u, int wr, int wc, int fr, int fq) const {
#pragma unroll
        for (int ai = 0; ai < 2; ++ai)
#pragma unroll
            for (int m = 0; m < 4; ++m) { const int row = u.pm * BM + ai * HALF + wr * 64 + m * 16 + fr;
                const float rs = row_rstd32(ssq, row, fq);
                f32x4 hv[2];
#pragma unroll
                for (int n = 0; n < 2; ++n) { const f32x4 gg = acc[ai][0][m][n] * rs, uu = acc[ai][1][m][n] * rs;
#pragma unroll
                    for (int e = 0; e < 4; ++e) hv[n][e] = gg[e] * __builtin_amdgcn_rcpf(1.f + __builtin_amdgcn_exp2f(-gg[e] * LOG2E)) * uu[e]; }
                *(u32x4*)(hid + (size_t)row * 5632 + u.pn * 128 + wc * 32 + fq * 8) = pack8(hv[0], hv[1]); }
    }
};
struct EpiGate {
    static constexpr bool PERM = true, AFTER_DRAIN = false;
    const bf16_t* xc; const float *ga_b, *gx_b, *spl; bf16_t *la, *uo;
    __device__ __forceinline__ void operator()(const f32x4 (&acc)[2][2][4][2], const Unit& u, int wr, int wc, int fr, int fq) const {
        const int c0 = u.pn * 128 + wc * 32 + fq * 8;
#pragma unroll
        for (int n = 0; n < 2; ++n) {
            const f32x4 ba = *(const f32x4*)(ga_b + c0 + 4 * n), bx = *(const f32x4*)(gx_b + c0 + 4 * n), sp = *(const f32x4*)(spl + c0 + 4 * n);
            u32x2 xws[2][4];
#pragma unroll
            for (int ai = 0; ai < 2; ++ai)
#pragma unroll
                for (int m = 0; m < 4; ++m) xws[ai][m] = *(const u32x2*)(xc + (size_t)(u.pm * BM + ai * HALF + wr * 64 + m * 16 + fr) * 1024 + c0 + 4 * n);
#pragma unroll
            for (int ai = 0; ai < 2; ++ai)
#pragma unroll
                for (int m = 0; m < 4; ++m) { const int row = u.pm * BM + ai * HALF + wr * 64 + m * 16 + fr;
                    const u32x2 xw = xws[ai][m];
                    const f32x4 xv = (f32x4){bf_lo(xw.x), bf_hi(xw.x), bf_lo(xw.y), bf_hi(xw.y)};
                    const f32x4 pa = acc[ai][0][m][n] + ba, px = acc[ai][1][m][n] + bx;
                    f32x4 lv, uv;
#pragma unroll
                    for (int e = 0; e < 4; ++e) {
                        const float ga = __builtin_amdgcn_rcpf(1.f + __builtin_amdgcn_exp2f(-pa[e] * LOG2E));
                        const float gx = __builtin_amdgcn_rcpf(1.f + __builtin_amdgcn_exp2f(-px[e] * LOG2E));
                        const float l2 = -ga * sp[e];
                        const float xl = 2.f * l2 * 0.6931471805599453f;
                        const float om = xl > -0.02f ? -(xl + xl * xl * (0.5f + xl * (1.f / 6.f))) : 1.f - __builtin_amdgcn_exp2f(2.f * l2);
                        lv[e] = l2; uv[e] = xv[e] * gx * __builtin_amdgcn_sqrtf(om); }
                    u32x2 lo, uo2; lo.x = cvt_pk_bf16(lv[0], lv[1]); lo.y = cvt_pk_bf16(lv[2], lv[3]); uo2.x = cvt_pk_bf16(uv[0], uv[1]); uo2.y = cvt_pk_bf16(uv[2], uv[3]);
                    *(u32x2*)(la + (size_t)row * 1024 + c0 + 4 * n) = lo;
                    *(u32x2*)(uo + (size_t)row * 1024 + c0 + 4 * n) = uo2; }
            asm volatile("" ::: "memory");
        }
    }
};

template <class Epi, class Sched, bool ALIGN_EPI = false, bool SP2 = false>
__device__ __forceinline__ void gemm_phase(PG8_LAS unsigned char* lds, const Gemm g, const Sched& S, const Epi& E) {
    int tid_ = threadIdx.x; asm volatile("" : "+v"(tid_));
    const int tid = tid_, wid = __builtin_amdgcn_readfirstlane(tid >> 6), lane = tid & 63, wr = wid >> 2, wc = wid & 3, fr = lane & 15, fq = lane >> 4;
    const int K = g.K, nt = K / BK;
    unsigned voffA[2], voffB[2];
#pragma unroll
    for (int i = 0; i < 2; ++i) { int R, C; stage_rc(tid * 16 + i * 8192, R, C); const int Rb = Epi::PERM ? ((R & ~31) + perm32(R & 31)) : R;
        voffA[i] = (unsigned)(R * g.lda + C) * 2u; voffB[i] = (unsigned)(Rb * g.ldb + C) * 2u; }
    const size_t kstep = (size_t)(BK * 2);
    const size_t hstepA = (size_t)HALF * g.lda * 2, hstepB = (size_t)HALF * g.ldb * 2;
    const size_t tstepA = 2 * hstepA, tstepB = 2 * hstepB, apnb = (size_t)g.apn * 2;
    const unsigned ldsw = (unsigned)wid * 1024u;
    const int aoff = lds_byte(wr * 64 + fr, fq * 8), boff = lds_byte(wc * 32 + fr, fq * 8);
#define PG8_SA(b, h) (((b) * 2 + (h)) * HTB)
#define PG8_SB(b, h) ((4 + (b) * 2 + (h)) * HTB)
#define PG8_STAGE(bufoff, gbase, voff) do { _Pragma("unroll") for (int _i = 0; _i < 2; ++_i) \
        __builtin_amdgcn_global_load_lds((const unsigned*)((const char*)(gbase) + (voff)[_i]), (PG8_LAS unsigned*)(lds + (bufoff) + ldsw + _i * 8192), 16, 0, 0); } while (0)
#define PG8_LDA(dst, b, h) do { _Pragma("unroll") for (int m = 0; m < 4; ++m) _Pragma("unroll") for (int k = 0; k < 2; ++k) dst[m][k] = *(const PG8_LAS bf16x8*)(lds + PG8_SA(b, h) + aoff + m * 2048 + k * 1024); } while (0)
#define PG8_LDB(dst, b, h) do { _Pragma("unroll") for (int n = 0; n < 2; ++n) _Pragma("unroll") for (int k = 0; k < 2; ++k) dst[n][k] = *(const PG8_LAS bf16x8*)(lds + PG8_SB(b, h) + boff + n * 2048 + k * 1024); } while (0)
#define PG8_MMA(ai, bj, At, Bt) do { __builtin_amdgcn_s_setprio(1); _Pragma("unroll") for (int m = 0; m < 4; ++m) _Pragma("unroll") for (int n = 0; n < 2; ++n) _Pragma("unroll") for (int k = 0; k < 2; ++k) \
        acc[ai][bj][m][n] = __builtin_amdgcn_mfma_f32_16x16x32_bf16(Bt[n][k], At[m][k], acc[ai][bj][m][n], 0, 0, 0); __builtin_amdgcn_s_setprio(0); } while (0)
#define PG8_WAIT_V(n) asm volatile("s_waitcnt vmcnt(" #n ")" ::: "memory")
#define PG8_WAIT_L(n) asm volatile("s_waitcnt lgkmcnt(" #n ")" ::: "memory")
#define PG8_BAR __builtin_amdgcn_s_barrier()
#define PG8_SCHED __builtin_amdgcn_sched_barrier(0)
    Unit cur, nxt; int ui = 0;
    if (!S.next(0, cur)) return;
    f32x4 acc[2][2][4][2];
#pragma unroll
    for (int a = 0; a < 2; ++a)
#pragma unroll
        for (int b = 0; b < 2; ++b)
#pragma unroll
            for (int m = 0; m < 4; ++m)
#pragma unroll
                for (int n = 0; n < 2; ++n) acc[a][b][m][n] = (f32x4){0.f, 0.f, 0.f, 0.f};
    bf16x8 At[4][2], B0[2][2], B1[2][2];
    const char* cA = (const char*)g.A + (size_t)cur.pm * tstepA + (size_t)cur.pn * apnb; const char* cB = (const char*)g.Bt + (size_t)cur.pn * tstepB;
    S.a_ready(cur);
    if constexpr (SP2) {
        PG8_STAGE(PG8_SB(0, 0), cB, voffB); PG8_STAGE(PG8_SB(0, 1), cB + hstepB, voffB); PG8_STAGE(PG8_SA(0, 0), cA, voffA); PG8_STAGE(PG8_SA(0, 1), cA + hstepA, voffA);
        if (wr == 1) PG8_BAR;
        PG8_WAIT_V(2); PG8_BAR;
        PG8_STAGE(PG8_SB(1, 0), cB + kstep, voffB); PG8_STAGE(PG8_SA(1, 0), cA + kstep, voffA); PG8_STAGE(PG8_SB(1, 1), cB + hstepB + kstep, voffB);
        PG8_WAIT_V(6); PG8_BAR;
    } else {
        PG8_STAGE(PG8_SB(0, 0), cB, voffB); PG8_STAGE(PG8_SA(0, 0), cA, voffA); PG8_STAGE(PG8_SB(0, 1), cB + hstepB, voffB); PG8_STAGE(PG8_SA(0, 1), cA + hstepA, voffA);
        if (wr == 1) PG8_BAR;
        PG8_WAIT_V(4); PG8_BAR;
        PG8_STAGE(PG8_SB(1, 0), cB + kstep, voffB); PG8_STAGE(PG8_SA(1, 0), cA + kstep, voffA); PG8_STAGE(PG8_SB(1, 1), cB + hstepB + kstep, voffB);
        PG8_WAIT_V(6); PG8_BAR;
    }
    for (;;) {
        const bool has_next = S.next(ui + 1, nxt);
        const char* nA = has_next ? (const char*)g.A + (size_t)nxt.pm * tstepA + (size_t)nxt.pn * apnb : cA; const char* nB = has_next ? (const char*)g.Bt + (size_t)nxt.pn * tstepB : cB;
        for (int t = 0; t < nt; t += 2) {
            const bool last = (t == nt - 2);
            const char* a1 = cA + (size_t)(t + 1) * kstep;
            const char* a2 = last ? nA : cA + (size_t)(t + 2) * kstep; const char* b2 = last ? nB : cB + (size_t)(t + 2) * kstep;
            const char* a3 = a2 + kstep; const char* b3 = b2 + kstep;
            if (last && has_next) S.a_ready(nxt);
            if constexpr (SP2) {
            PG8_LDB(B0, 0, 0); PG8_LDB(B1, 0, 1); PG8_SCHED; PG8_LDA(At, 0, 0); PG8_STAGE(PG8_SA(1, 1), a1 + hstepA, voffA);
            PG8_WAIT_V(8); PG8_WAIT_L(0); PG8_BAR; PG8_MMA(0, 0, At, B0); PG8_MMA(0, 1, At, B1); PG8_BAR; PG8_SCHED;
            PG8_LDA(At, 0, 1); PG8_STAGE(PG8_SB(0, 0), b2, voffB); PG8_STAGE(PG8_SB(0, 1), b2 + hstepB, voffB); PG8_STAGE(PG8_SA(0, 0), a2, voffA);
            PG8_WAIT_V(8); PG8_WAIT_L(0); PG8_BAR; PG8_MMA(1, 0, At, B0); PG8_MMA(1, 1, At, B1); PG8_BAR; PG8_SCHED;
            PG8_LDB(B0, 1, 0); PG8_LDB(B1, 1, 1); PG8_SCHED; PG8_LDA(At, 1, 0); PG8_STAGE(PG8_SA(0, 1), a2 + hstepA, voffA);
            PG8_WAIT_V(8); PG8_WAIT_L(0); PG8_BAR; PG8_MMA(0, 0, At, B0); PG8_MMA(0, 1, At, B1); PG8_BAR; PG8_SCHED;
            PG8_LDA(At, 1, 1); PG8_STAGE(PG8_SB(1, 0), b3, voffB); PG8_STAGE(PG8_SB(1, 1), b3 + hstepB, voffB); PG8_STAGE(PG8_SA(1, 0), a3, voffA);
            PG8_WAIT_V(8); PG8_WAIT_L(0); PG8_BAR; PG8_MMA(1, 0, At, B0); PG8_MMA(1, 1, At, B1); PG8_BAR; PG8_SCHED;
            } else {
            PG8_LDB(B0, 0, 0); PG8_SCHED; PG8_LDA(At, 0, 0); PG8_STAGE(PG8_SA(1, 1), a1 + hstepA, voffA);
            PG8_WAIT_L(8); PG8_BAR; PG8_WAIT_L(0); PG8_MMA(0, 0, At, B0); PG8_BAR; PG8_SCHED;
            PG8_LDB(B1, 0, 1); PG8_STAGE(PG8_SB(0, 0), b2, voffB);
            PG8_BAR; PG8_WAIT_L(0); PG8_MMA(0, 1, At, B1); PG8_BAR;
            PG8_LDA(At, 0, 1); PG8_STAGE(PG8_SA(0, 0), a2, voffA);
            PG8_BAR; PG8_WAIT_L(0); PG8_MMA(1, 0, At, B0); PG8_BAR; PG8_SCHED;
            PG8_STAGE(PG8_SB(0, 1), b2 + hstepB, voffB);
            PG8_WAIT_V(6); PG8_BAR; PG8_MMA(1, 1, At, B1); PG8_BAR;
            PG8_LDB(B0, 1, 0); PG8_SCHED; PG8_LDA(At, 1, 0); PG8_STAGE(PG8_SA(0, 1), a2 + hstepA, voffA);
            PG8_WAIT_L(8); PG8_BAR; PG8_WAIT_L(0); PG8_MMA(0, 0, At, B0); PG8_BAR; PG8_SCHED;
            PG8_LDB(B1, 1, 1); PG8_STAGE(PG8_SB(1, 0), b3, voffB);
            PG8_BAR; PG8_WAIT_L(0); PG8_MMA(0, 1, At, B1); PG8_BAR;
            PG8_LDA(At, 1, 1); PG8_STAGE(PG8_SA(1, 0), a3, voffA);
            PG8_BAR; PG8_WAIT_L(0); PG8_MMA(1, 0, At, B0); PG8_BAR; PG8_SCHED;
            PG8_STAGE(PG8_SB(1, 1), b3 + hstepB, voffB);
            PG8_WAIT_V(6); PG8_BAR; PG8_MMA(1, 1, At, B1); PG8_BAR;
            }
        }
        if constexpr (ALIGN_EPI) { if (wr == 0) PG8_BAR; }
        if constexpr (!Epi::AFTER_DRAIN) { E(acc, cur, wr, wc, fr, fq); S.done(cur); }
        if (!has_next) break;
#pragma unroll
        for (int a = 0; a < 2; ++a)
#pragma unroll
            for (int b = 0; b < 2; ++b)
#pragma unroll
                for (int m = 0; m < 4; ++m)
#pragma unroll
                    for (int n = 0; n < 2; ++n) acc[a][b][m][n] = (f32x4){0.f, 0.f, 0.f, 0.f};
        cur = nxt; cA = nA; cB = nB; ++ui;
        if constexpr (ALIGN_EPI) { if (wr == 1) PG8_BAR; }
    }
    PG8_WAIT_V(0);
    if constexpr (!ALIGN_EPI) { if (wr == 0) PG8_BAR; }
    PG8_BAR;
    if constexpr (Epi::AFTER_DRAIN) { E.fused(acc, cur, wr, wc, fr, fq, lds, wid, lane); S.done(cur); }
#undef PG8_SA
#undef PG8_SB
#undef PG8_STAGE
#undef PG8_LDA
#undef PG8_LDB
#undef PG8_MMA
#undef PG8_WAIT_V
#undef PG8_WAIT_L
#undef PG8_BAR
#undef PG8_SCHED
}
}
using namespace pg8;
#define GLOBAL_AS __attribute__((address_space(1)))
constexpr int SEQ = 16384, DM = 2048, AW = 1024, RW = 1024, INW = 5120, XW = 512, DFF = 5632, MEML = 256;
constexpr int NTHREADS = 512, NWAVES = 8;
constexpr int LDS_BYTES = 147456;
constexpr size_t KiB = 1024, MiB = 1u << 20;
constexpr size_t WS_RSTD1 = 0, WS_SSQ2 = 64 * KiB, WS_SSQ3 = 128 * KiB, WS_SPL = 192 * KiB, WS_BAR = 208 * KiB  , WS_MKRAW = 256 * KiB, WS_MKN = 768 * KiB, WS_MVT = 1 * MiB;
constexpr size_t WS_MEMN = 2 * MiB, WS_AS = 3 * MiB, WS_HEND = 4 * MiB, WS_WGATE = 5 * MiB, WS_WA = 6 * MiB, WS_WV = 22 * MiB, WS_WOUT = 26 * MiB;
constexpr size_t WS_WXQ = 34 * MiB, WS_WXK = 36 * MiB, WS_WXV = 38 * MiB, WS_WXO = 40 * MiB, WS_WGU = 42 * MiB, WS_WDN = 86 * MiB, WS_XB = 108 * MiB;
constexpr size_t WS_Q = 172 * MiB, WS_K = 204 * MiB, WS_VT = 236 * MiB, WS_XR = 268 * MiB, WS_YR = 300 * MiB, WS_XC = 332 * MiB, WS_HID = 172 * MiB;
constexpr size_t WS_LA = 364 * MiB, WS_U = 396 * MiB, WS_MIX = 428 * MiB, WS_XQ = 364 * MiB, WS_XOIN = 380 * MiB, WS_SSQP2 = 492 * MiB, WS_SSQP3 = 494 * MiB, WS_END = 496 * MiB;

struct Args { const float* in[32]; float* out; unsigned char* ws; };
enum { I_X = 0, I_MEM, I_RELB, I_ATTN_NORM, I_W_IN, I_QN, I_KN, I_LQ1, I_LK1, I_LQ2, I_LK2, I_SUBLN, I_CONV_W, I_CONV_B, I_GA_W, I_GA_B, I_GX_W, I_GX_B,
       I_RGL, I_RNN_NORM, I_W_OUT, I_XATTN_NORM, I_MEM_NORM, I_XQ_W, I_XK_W, I_XV_W, I_XQ_NORM, I_XK_NORM, I_XO_W, I_FFN_NORM, I_W_GU, I_W_DN };

__device__ __forceinline__ float wave_sum(float v) {
#pragma unroll
    for (int o = 1; o < 64; o <<= 1) v += __shfl_xor(v, o);
    return v;
}
#define LDS_WAIT() asm volatile("s_waitcnt lgkmcnt(0)" ::: "memory")

__device__ __forceinline__ void xpose_item(const float* W, int ldw, int csrc, const float* gain, bf16_t* WT, int ldt, int drow, int k0, LAS float* scr, int lane) {
    f32x4 wv[8];
#pragma unroll
    for (int i = 0; i < 8; ++i) wv[i] = __builtin_nontemporal_load((const f32x4*)(W + (size_t)(k0 + 8 * i + (lane >> 3)) * ldw + csrc + (lane & 7) * 4));
    if (gain) {
#pragma unroll
        for (int i = 0; i < 8; ++i) wv[i] = wv[i] * gain[k0 + 8 * i + (lane >> 3)]; }
#pragma unroll
    for (int i = 0; i < 8; ++i) { LAS float* d = scr + (8 * i + (lane >> 3)) * 33 + (lane & 7) * 4; d[0] = wv[i][0]; d[1] = wv[i][1]; d[2] = wv[i][2]; d[3] = wv[i][3]; }
    LDS_WAIT(); asm volatile("" ::: "memory");
    const int c = lane & 7;
#pragma unroll
    for (int j = 0; j < 4; ++j) { const int n = (lane >> 3) + 8 * j; const LAS float* s = scr + (8 * c) * 33 + n;
        u32x4 o; o.x = cvt_pk_bf16(s[0 * 33], s[1 * 33]); o.y = cvt_pk_bf16(s[2 * 33], s[3 * 33]); o.z = cvt_pk_bf16(s[4 * 33], s[5 * 33]); o.w = cvt_pk_bf16(s[6 * 33], s[7 * 33]);
        *(u32x4*)(WT + (size_t)(drow + n) * ldt + k0 + 8 * c) = o; }
    LDS_WAIT(); asm volatile("" ::: "memory");
}
__device__ __forceinline__ float row_to_bf16(const float* xrow, bf16_t* orow, const float* gain, bool normalize, int lane) {
    const f32x4* xr = (const f32x4*)xrow + lane;
    f32x4 v[8]; float s = 0.f;
#pragma unroll
    for (int j = 0; j < 8; ++j) { v[j] = __builtin_nontemporal_load(xr + 64 * j); const f32x4 t = v[j] * v[j]; s += (t[0] + t[1]) + (t[2] + t[3]); }
    const float rstd = rsqrtf(wave_sum(s) * (1.f / 2048.f) + EPSF);
    u32x2* o8 = (u32x2*)orow + lane;
#pragma unroll
    for (int j = 0; j < 8; ++j) { f32x4 w = v[j];
        if (normalize) { const f32x4 g = *((const f32x4*)gain + lane + 64 * j); w = w * rstd * g; }
        u32x2 o; o.x = cvt_pk_bf16(w[0], w[1]); o.y = cvt_pk_bf16(w[2], w[3]); o8[64 * j] = o; }
    return rstd;
}

__device__ __forceinline__ void p0_prologue(const Args& a, LAS unsigned char* lds, int G, int bid, int tid) {
    const int wave = __builtin_amdgcn_readfirstlane(tid >> 6), lane = tid & 63;
    unsigned char* ws = a.ws;
    LAS float* scr = (LAS float*)(lds + wave * 16384);
    const int gw = bid * NWAVES + wave, NGW = G * NWAVES;
    constexpr int J0 = 32 * 160, J1 = 32 * 64, J2 = 32 * 16, J5 = 8 * 64, J6 = 32 * 352, J7 = 88 * 64, J8 = 128;
    constexpr int NITEMS = J0 + J1 + 3 * J2 + J5 + J6 + J8;
    for (int it = gw; it < NITEMS; it += NGW) {
        int r = it;
        if (r < J0) { const int kb = r / 160, ng = r % 160, n0 = 32 * ng, region = n0 >> 10;
            if (region == 2) xpose_item(a.in[I_W_IN], INW, n0, a.in[I_ATTN_NORM], (bf16_t*)(ws + WS_WV), DM, n0 - 2048, 64 * kb, scr, lane);
            else { const int L = n0 - (region > 2 ? 1024 : 0), tile = L >> 8, j = L & 255, wc = j >> 6, bj = (j >> 5) & 1;
                xpose_item(a.in[I_W_IN], INW, n0, a.in[I_ATTN_NORM], (bf16_t*)(ws + WS_WA), DM, tile * 256 + 128 * bj + 32 * wc, 64 * kb, scr, lane); }
            continue; } r -= J0;
        if (r < J1) { xpose_item(a.in[I_W_OUT], DM, 32 * (r % 64), nullptr, (bf16_t*)(ws + WS_WOUT), DM, 32 * (r % 64), 64 * (r / 64), scr, lane); continue; } r -= J1;
        if (r < J2) { xpose_item(a.in[I_XQ_W], XW, 32 * (r % 16), a.in[I_XATTN_NORM], (bf16_t*)(ws + WS_WXQ), DM, 32 * (r % 16), 64 * (r / 16), scr, lane); continue; } r -= J2;
        if (r < J2) { xpose_item(a.in[I_XK_W], XW, 32 * (r % 16), nullptr, (bf16_t*)(ws + WS_WXK), DM, 32 * (r % 16), 64 * (r / 16), scr, lane); continue; } r -= J2;
        if (r < J2) { xpose_item(a.in[I_XV_W], XW, 32 * (r % 16), nullptr, (bf16_t*)(ws + WS_WXV), DM, 32 * (r % 16), 64 * (r / 16), scr, lane); continue; } r -= J2;
        if (r < J5) { xpose_item(a.in[I_XO_W], DM, 32 * (r % 64), nullptr, (bf16_t*)(ws + WS_WXO), XW, 32 * (r % 64), 64 * (r / 64), scr, lane); continue; } r -= J5;
        if (r < J6) { const int kb = r / 352, pg = r % 352, p0 = 32 * pg, T = p0 >> 8, rem = p0 & 255, bj = rem >> 7, r2 = rem & 127;
            xpose_item(a.in[I_W_GU], 2 * DFF, bj * DFF + 128 * T + r2, a.in[I_FFN_NORM], (bf16_t*)(ws + WS_WGU), DM, p0, 64 * kb, scr, lane); continue; } r -= J6;
        { const int gi = r >> 4, which = (r >> 3) & 1, sub = r & 7, kb = sub >> 2, nb = sub & 3;
          xpose_item(a.in[which ? I_GX_W : I_GA_W] + (size_t)gi * 128 * 128, 128, 32 * nb, nullptr, (bf16_t*)(ws + WS_WGATE), 128, gi * 256 + which * 128 + 32 * nb, 64 * kb, scr, lane); }
    }
    float* rstd1 = (float*)(ws + WS_RSTD1);
    for (int grp = bid; grp < SEQ / 32; grp += G)
        for (int k = 0; k < 4; ++k) { const int m = grp * 32 + k * 8 + wave; const float rs = row_to_bf16(a.in[I_X] + (size_t)m * DM, (bf16_t*)(ws + WS_XB) + (size_t)m * DM, nullptr, false, lane); if (lane == 0) rstd1[m] = rs; }
    for (int m = gw; m < MEML; m += NGW) row_to_bf16(a.in[I_MEM] + (size_t)m * DM, (bf16_t*)(ws + WS_MEMN) + (size_t)m * DM, a.in[I_MEM_NORM], true, lane);
    for (int c = bid * NTHREADS + tid; c < RW; c += G * NTHREADS) ((float*)(ws + WS_SPL))[c] = 8.f * LOG2E * log1pf(expf(-a.in[I_RGL][c]));
}

__device__ __forceinline__ void wdn_convert(const Args& a, LAS unsigned char* lds, int nb, int rk, int tid) {
    const int wave = __builtin_amdgcn_readfirstlane(tid >> 6), lane = tid & 63;
    LAS float* scr = (LAS float*)(lds + wave * 16384);
    for (int r = rk * NWAVES + wave; r < 88 * 64; r += nb * NWAVES)
        xpose_item(a.in[I_W_DN], DM, 32 * (r % 64), nullptr, (bf16_t*)(a.ws + WS_WDN), DFF, 32 * (r % 64), 64 * (r / 64), scr, lane);
}
__device__ __forceinline__ void mk_norm_phase(const Args& a, int G, int bid, int tid) {
    const int wave = tid >> 6, lane = tid & 63;
    const float* raw = (const float*)(a.ws + WS_MKRAW); bf16_t* mkn = (bf16_t*)(a.ws + WS_MKN);
    for (int p = bid * NWAVES + wave; p < MEML * 4; p += G * NWAVES) {
        const float2 v = *(const float2*)(raw + (size_t)p * 128 + 2 * lane);
        const float r = rsqrtf(wave_sum(v.x * v.x + v.y * v.y) * (1.f / 128.f) + EPSF);
        const float2 g = *(const float2*)(a.in[I_XK_NORM] + 2 * lane);
        *(unsigned*)(mkn + (size_t)p * 128 + 2 * lane) = cvt_pk_bf16(v.x * r * g.x, v.y * r * g.y);
    }
}
__device__ __forceinline__ void mk_norm_cols(const Args& a, int pn, int tid) {
    const int wave = tid >> 6, lane = tid & 63;
    const float* raw = (const float*)(a.ws + WS_MKRAW); bf16_t* mkn = (bf16_t*)(a.ws + WS_MKN);
    for (int q = wave; q < MEML * 2; q += NWAVES) { const int row = q >> 1, head = pn * 2 + (q & 1); const size_t p = (size_t)row * 4 + head;
        const float2 v = *(const float2*)(raw + p * 128 + 2 * lane);
        const float r = rsqrtf(wave_sum(v.x * v.x + v.y * v.y) * (1.f / 128.f) + EPSF);
        const float2 g = *(const float2*)(a.in[I_XK_NORM] + 2 * lane);
        *(unsigned*)(mkn + p * 128 + 2 * lane) = cvt_pk_bf16(v.x * r * g.x, v.y * r * g.y); }
}
__device__ __forceinline__ void conv_phase(const Args& a, int G, int bid, int tid) {
    const bf16_t* xr = (const bf16_t*)(a.ws + WS_XR); bf16_t* xc = (bf16_t*)(a.ws + WS_XC);
    const int cg8 = (tid & 127) * 8, rsub = tid >> 7;
    float w[4][8], b[8];
#pragma unroll
    for (int j = 0; j < 4; ++j)
#pragma unroll
        for (int e = 0; e < 8; ++e) w[j][e] = a.in[I_CONV_W][j * RW + cg8 + e];
#pragma unroll
    for (int e = 0; e < 8; ++e) b[e] = a.in[I_CONV_B][cg8 + e];
    for (int it = bid; it < SEQ / 32; it += G) {
        const int t0 = it * 32 + rsub * 8;
        float win[3][8];
#pragma unroll
        for (int j = 0; j < 3; ++j) { const int t = t0 - 3 + j; u32x4 x = (u32x4){0u, 0u, 0u, 0u}; if (t >= 0) x = *(const u32x4*)(xr + (size_t)t * RW + cg8);
            win[j][0] = bf_lo(x.x); win[j][1] = bf_hi(x.x); win[j][2] = bf_lo(x.y); win[j][3] = bf_hi(x.y); win[j][4] = bf_lo(x.z); win[j][5] = bf_hi(x.z); win[j][6] = bf_lo(x.w); win[j][7] = bf_hi(x.w); }
#pragma unroll
        for (int i = 0; i < 8; ++i) { const int t = t0 + i; const u32x4 x = *(const u32x4*)(xr + (size_t)t * RW + cg8);
            float cur[8] = {bf_lo(x.x), bf_hi(x.x), bf_lo(x.y), bf_hi(x.y), bf_lo(x.z), bf_hi(x.z), bf_lo(x.w), bf_hi(x.w)};
            float o[8];
#pragma unroll
            for (int e = 0; e < 8; ++e) { o[e] = b[e] + w[0][e] * win[0][e] + w[1][e] * win[1][e] + w[2][e] * win[2][e] + w[3][e] * cur[e]; win[0][e] = win[1][e]; win[1][e] = win[2][e]; win[2][e] = cur[e]; }
            u32x4 ow; ow.x = cvt_pk_bf16(o[0], o[1]); ow.y = cvt_pk_bf16(o[2], o[3]); ow.z = cvt_pk_bf16(o[4], o[5]); ow.w = cvt_pk_bf16(o[6], o[7]);
            *(u32x4*)(xc + (size_t)t * RW + cg8) = ow; }
    }
}
#define MFMA32(a, b, c) __builtin_amdgcn_mfma_f32_32x32x16_bf16((a), (b), (c), 0, 0, 0)
__device__ __forceinline__ void rnn_front_phase(const Args& a, LAS unsigned char* lds, int G, int bid, int tid) {
    const int wid = __builtin_amdgcn_readfirstlane(tid >> 6), lane = tid & 63, r = lane & 31, h = lane >> 5;
    const bf16_t* XR = (const bf16_t*)(a.ws + WS_XR); const bf16_t* WG = (const bf16_t*)(a.ws + WS_WGATE);
    bf16_t* LAo = (bf16_t*)(a.ws + WS_LA); bf16_t* Uo = (bf16_t*)(a.ws + WS_U);
    float* As = (float*)(a.ws + WS_AS); float* He = (float*)(a.ws + WS_HEND);
    LAS float* LAb = (LAS float*)(lds + 49152); LAS float* Ub = (LAS float*)(lds + 81920);
    LAS float* GX = (LAS float*)(lds + 16384) + (wid & 3) * 2048;
    int gcur = -1; bf16x8 Bf[8];
    float ba = 0.f, bx = 0.f, sp = 0.f;
    u32x4 xq[5];
#define RNN_LOADX(itx) do { const int g_ = (itx) & 7, j_ = (itx) >> 3, co_ = tid & 15, rp_ = tid >> 4; \
        _Pragma("unroll") for (int q = 0; q < 5; ++q) { const int t = 64 * j_ + 2 * rp_ - 3 + q; xq[q] = (u32x4){0u, 0u, 0u, 0u}; if (t >= 0) xq[q] = *(const u32x4*)(XR + (size_t)t * RW + 128 * g_ + co_ * 8); } } while (0)
    if (bid < (SEQ / 64) * 8) RNN_LOADX(bid);
    for (int it = bid; it < (SEQ / 64) * 8; it += G) {
        const int g = it & 7, j = it >> 3, t0 = 64 * j, c0 = 128 * g;
        if (g != gcur) { gcur = g;
#pragma unroll
            for (int s = 0; s < 8; ++s) Bf[s] = *(const bf16x8*)(WG + (size_t)(g * 256 + 32 * wid + r) * 128 + 16 * s + 8 * h);
            const int cgh = c0 + (wid & 3) * 32 + r;
            ba = a.in[I_GA_B][cgh]; bx = a.in[I_GX_B][cgh]; sp = ((const float*)(a.ws + WS_SPL))[cgh]; }
        { const int co = tid & 15, rp = tid >> 4, ch = c0 + co * 8;
          float acc0[8], acc1[8];
#pragma unroll
          for (int e = 0; e < 8; ++e) { acc0[e] = a.in[I_CONV_B][ch + e]; acc1[e] = acc0[e]; }
#pragma unroll
          for (int jj = 0; jj < 4; ++jj) { const f32x4 w0 = *(const f32x4*)(a.in[I_CONV_W] + jj * RW + ch), w1 = *(const f32x4*)(a.in[I_CONV_W] + jj * RW + ch + 4);
              const u32x4 xa = xq[jj], xb = xq[jj + 1];
              const float va[8] = {bf_lo(xa.x), bf_hi(xa.x), bf_lo(xa.y), bf_hi(xa.y), bf_lo(xa.z), bf_hi(xa.z), bf_lo(xa.w), bf_hi(xa.w)};
              const float vb[8] = {bf_lo(xb.x), bf_hi(xb.x), bf_lo(xb.y), bf_hi(xb.y), bf_lo(xb.z), bf_hi(xb.z), bf_lo(xb.w), bf_hi(xb.w)};
#pragma unroll
              for (int e = 0; e < 8; ++e) { const float wv = e < 4 ? w0[e & 3] : w1[e & 3]; acc0[e] += wv * va[e]; acc1[e] += wv * vb[e]; } }
          const int r0 = 2 * rp, r1 = 2 * rp + 1;
          u32x4 o0, o1; o0.x = cvt_pk_bf16(acc0[0], acc0[1]); o0.y = cvt_pk_bf16(acc0[2], acc0[3]); o0.z = cvt_pk_bf16(acc0[4], acc0[5]); o0.w = cvt_pk_bf16(acc0[6], acc0[7]);
          o1.x = cvt_pk_bf16(acc1[0], acc1[1]); o1.y = cvt_pk_bf16(acc1[2], acc1[3]); o1.z = cvt_pk_bf16(acc1[4], acc1[5]); o1.w = cvt_pk_bf16(acc1[6], acc1[7]);
          *(LAS u32x4*)(lds + r0 * 256 + ((co ^ (r0 & 15)) << 4)) = o0;
          *(LAS u32x4*)(lds + r1 * 256 + ((co ^ (r1 & 15)) << 4)) = o1; }
        __syncthreads();
        f32x16 D[2];
#pragma unroll
        for (int mt = 0; mt < 2; ++mt) {
#pragma unroll
            for (int i = 0; i < 16; ++i) D[mt][i] = 0.f;
            const int row = 32 * mt + r;
#pragma unroll
            for (int s = 0; s < 8; ++s) { const bf16x8 xa = *(const LAS bf16x8*)(lds + row * 256 + (((2 * s + h) ^ (row & 15)) << 4)); D[mt] = MFMA32(xa, Bf[s], D[mt]); } }
        const int cl = (wid & 3) * 32 + r, cgl = c0 + cl;
        if (wid < 4) {
#pragma unroll
            for (int i = 0; i < 16; ++i) GX[1024 + i * 64 + lane] = D[1][i]; }
        else {
#pragma unroll
            for (int i = 0; i < 16; ++i) GX[i * 64 + lane] = D[0][i]; }
        __syncthreads();
        {
#define RNN_FIN(PA, PX, MT) do { _Pragma("unroll") for (int i = 0; i < 16; ++i) { const int row = 32 * (MT) + (i & 3) + 8 * (i >> 2) + 4 * h; \
                const float ga = __builtin_amdgcn_rcpf(1.f + __builtin_amdgcn_exp2f(-((PA) + ba) * LOG2E)); \
                const float gx = __builtin_amdgcn_rcpf(1.f + __builtin_amdgcn_exp2f(-((PX) + bx) * LOG2E)); \
                const float l2 = -ga * sp; \
                const float xl = 2.f * l2 * 0.6931471805599453f; \
                const float om = xl > -0.02f ? -(xl + xl * xl * (0.5f + xl * (1.f / 6.f))) : 1.f - __builtin_amdgcn_exp2f(2.f * l2); \
                const float xcv = bf_lo((unsigned)*(const LAS unsigned short*)(lds + row * 256 + (((cl >> 3) ^ (row & 15)) << 4) + (cl & 7) * 2)); \
                const float uv = xcv * gx * __builtin_amdgcn_sqrtf(om); \
                LAb[row * 128 + cl] = bf_lo(cvt_pk_bf16(l2, 0.f)); Ub[row * 128 + cl] = bf_lo(cvt_pk_bf16(uv, 0.f)); } } while (0)
          if (wid < 4) RNN_FIN(D[0][i], GX[i * 64 + lane], 0);
          else RNN_FIN(GX[1024 + i * 64 + lane], D[1][i], 1);
#undef RNN_FIN
        }
        __syncthreads();
        if (it + G < (SEQ / 64) * 8) RNN_LOADX(it + G);
#pragma unroll
        for (int q = 0; q < 2; ++q) { const int idx = tid + NTHREADS * q, row = idx >> 4, oc = idx & 15;
            const f32x4 l0 = *(const LAS f32x4*)(LAb + row * 128 + oc * 8), l1 = *(const LAS f32x4*)(LAb + row * 128 + oc * 8 + 4);
            const f32x4 u0 = *(const LAS f32x4*)(Ub + row * 128 + oc * 8), u1 = *(const LAS f32x4*)(Ub + row * 128 + oc * 8 + 4);
            *(u32x4*)(LAo + (size_t)(t0 + row) * RW + c0 + oc * 8) = pack8(l0, l1);
            *(u32x4*)(Uo + (size_t)(t0 + row) * RW + c0 + oc * 8) = pack8(u0, u1); }
        if (tid < 128) { float hh = 0.f, ssum = 0.f;
#pragma unroll 16
            for (int t = 0; t < 64; ++t) { const float l = LAb[t * 128 + tid], uu = Ub[t * 128 + tid]; ssum += l; hh = __builtin_amdgcn_exp2f(l) * hh + uu; }
            As[(size_t)j * RW + c0 + tid] = __builtin_amdgcn_exp2f(ssum); He[(size_t)j * RW + c0 + tid] = hh; }
    }
#undef RNN_LOADX
}
__device__ __forceinline__ void scanA_phase(const Args& a, int G, int bid, int tid) {
    const bf16_t* la = (const bf16_t*)(a.ws + WS_LA); const bf16_t* uu = (const bf16_t*)(a.ws + WS_U);
    float* As = (float*)(a.ws + WS_AS); float* He = (float*)(a.ws + WS_HEND);
    for (int ch = bid; ch < SEQ / 64; ch += G) {
        float h0 = 0.f, h1 = 0.f, s0 = 0.f, s1 = 0.f;
        const size_t base = (size_t)ch * 64 * RW + 2 * tid;
#pragma unroll 16
        for (int t = 0; t < 64; ++t) { const unsigned l = *(const unsigned*)(la + base + (size_t)t * RW), u = *(const unsigned*)(uu + base + (size_t)t * RW);
            const float l0 = bf_lo(l), l1 = bf_hi(l); s0 += l0; s1 += l1;
            h0 = __builtin_amdgcn_exp2f(l0) * h0 + bf_lo(u); h1 = __builtin_amdgcn_exp2f(l1) * h1 + bf_hi(u); }
        *(float2*)(As + (size_t)ch * RW + 2 * tid) = make_float2(s0, s1);
        *(float2*)(He + (size_t)ch * RW + 2 * tid) = make_float2(h0, h1);
    }
}
__device__ __forceinline__ float gelu_tanh(float y) {
    const float z = 0.7978845608028654f * (y + 0.044715f * y * y * y);
    const float e = __builtin_amdgcn_exp2f(2.f * LOG2E * z);
    const float th = 1.f - 2.f * __builtin_amdgcn_rcpf(1.f + e);
    return 0.5f * y * (1.f + th);
}
__device__ __forceinline__ void scanC_phase(const Args& a, LAS unsigned char* lds, int G, int bid, int tid) {
    const bf16_t* la = (const bf16_t*)(a.ws + WS_LA); const bf16_t* uu = (const bf16_t*)(a.ws + WS_U); const bf16_t* yr = (const bf16_t*)(a.ws + WS_YR);
    const float* As = (const float*)(a.ws + WS_AS); const float* He = (const float*)(a.ws + WS_HEND);
    bf16_t* mix = (bf16_t*)(a.ws + WS_MIX);
    const int wave = tid >> 6, lane = tid & 63;
    for (int ch = bid; ch < SEQ / 64; ch += G) {
        float h0 = 0.f, h1 = 0.f;
#pragma unroll 32
        for (int j = 0; j < ch; ++j) { const float2 s = *(const float2*)(As + (size_t)j * RW + 2 * tid), e = *(const float2*)(He + (size_t)j * RW + 2 * tid);
            h0 = s.x * h0 + e.x; h1 = s.y * h1 + e.y; }
        const size_t base = (size_t)ch * 64 * RW + 2 * tid;
#pragma unroll 16
        for (int t = 0; t < 64; ++t) { const unsigned l = *(const unsigned*)(la + base + (size_t)t * RW), u = *(const unsigned*)(uu + base + (size_t)t * RW), y = *(const unsigned*)(yr + base + (size_t)t * RW);
            h0 = __builtin_amdgcn_exp2f(bf_lo(l)) * h0 + bf_lo(u); h1 = __builtin_amdgcn_exp2f(bf_hi(l)) * h1 + bf_hi(u);
            *(LAS unsigned*)(lds + t * 2048 + tid * 4) = cvt_pk_bf16(h0 * gelu_tanh(bf_lo(y)), h1 * gelu_tanh(bf_hi(y))); }
        __syncthreads();
#pragma unroll
        for (int rr = 0; rr < 8; ++rr) { const int t = wave * 8 + rr;
            const u32x4 x0 = *(const LAS u32x4*)(lds + t * 2048 + lane * 16), x1 = *(const LAS u32x4*)(lds + t * 2048 + 1024 + lane * 16);
            float v[16] = {bf_lo(x0.x), bf_hi(x0.x), bf_lo(x0.y), bf_hi(x0.y), bf_lo(x0.z), bf_hi(x0.z), bf_lo(x0.w), bf_hi(x0.w),
                           bf_lo(x1.x), bf_hi(x1.x), bf_lo(x1.y), bf_hi(x1.y), bf_lo(x1.z), bf_hi(x1.z), bf_lo(x1.w), bf_hi(x1.w)};
            float ss = 0.f;
#pragma unroll
            for (int e = 0; e < 16; ++e) ss += v[e] * v[e];
            const float r = rsqrtf(wave_sum(ss) * (1.f / 1024.f) + EPSF);
            const float* gn = a.in[I_RNN_NORM];
#pragma unroll
            for (int hh = 0; hh < 2; ++hh) { const int c = hh * 512 + lane * 8; const f32x4 g0 = *(const f32x4*)(gn + c), g1 = *(const f32x4*)(gn + c + 4);
                u32x4 o; o.x = cvt_pk_bf16(v[8 * hh + 0] * r * g0[0], v[8 * hh + 1] * r * g0[1]); o.y = cvt_pk_bf16(v[8 * hh + 2] * r * g0[2], v[8 * hh + 3] * r * g0[3]);
                o.z = cvt_pk_bf16(v[8 * hh + 4] * r * g1[0], v[8 * hh + 5] * r * g1[1]); o.w = cvt_pk_bf16(v[8 * hh + 6] * r * g1[2], v[8 * hh + 7] * r * g1[3]);
                *(u32x4*)(mix + (size_t)(ch * 64 + t) * DM + AW + c) = o; } }
        __syncthreads();
    }
}
__device__ __forceinline__ int t5_bucket(int rel) {
    const int n = rel < 0 ? -rel : rel;
    int large = 8 + (int)(logf((float)(n < 1 ? 1 : n) / 8.0f) / 4.852030263919617f * 8.0f);
    large = large < 15 ? large : 15;
    return (rel > 0 ? 16 : 0) + (n < 8 ? n : large);
}
__device__ __forceinline__ void attn_phase(const Args& a, LAS unsigned char* lds, int G, int bid, int tid) {
    const int wid = __builtin_amdgcn_readfirstlane(tid >> 6), lane = tid & 63, r = lane & 31, h = lane >> 5;
    const bf16_t* Q = (const bf16_t*)(a.ws + WS_Q); const bf16_t* Kb = (const bf16_t*)(a.ws + WS_K); const bf16_t* VT = (const bf16_t*)(a.ws + WS_VT);
    bf16_t* mix = (bf16_t*)(a.ws + WS_MIX);
    LAS float* tab = (LAS float*)(lds + 132096);
    float lam;
    { const float s1 = wave_sum(a.in[I_LQ1][lane] * a.in[I_LK1][lane]), s2 = wave_sum(a.in[I_LQ2][lane] * a.in[I_LK2][lane]); lam = __uint_as_float(__builtin_amdgcn_readfirstlane(__float_as_uint(expf(s1) - expf(s2) + 0.2f))); }
    const int rowk = (r & 0x13) | ((r & 4) << 1) | ((r & 8) >> 1);
    const int koff0 = rowk * 128 + ((h ^ ((rowk >> 1) & 7)) << 4), voff0 = r * 128 + ((h ^ ((r >> 1) & 7)) << 4);
#define KOFF(s) (koff0 ^ ((s) << 5))
#define VOFF(s) (16384 + (voff0 ^ ((s) << 5)))
    const unsigned ldsw = (unsigned)wid * 1024u;

    int tabhead = -1;
    for (int ui = 0;; ++ui) {
        const int uidx = ui * G + bid; if (uidx >= 512) break;
        const int cc = uidx & 255, rnd = uidx >> 8, head = cc & 7, jj = cc >> 3;
        const int qb = rnd == 0 ? 63 - jj : jj;
        const int q0 = qb * 256, nst = 2 * qb + 2, cw = 4 * qb + (wid >> 1), qw = q0 + 32 * wid;
        int tu_ = threadIdx.x; asm volatile("" : "+v"(tu_));
        if (head != tabhead) { tabhead = head;
            for (int idx = tu_; idx < 1408; idx += NTHREADS) tab[idx] = a.in[I_RELB][t5_bucket(63 - idx) * 8 + head] * LOG2E; }
        const float farb = a.in[I_RELB][15 * 8 + head] * LOG2E;
        bf16x8 Qf[2][4];
#pragma unroll
        for (int mp = 0; mp < 2; ++mp)
#pragma unroll
            for (int s = 0; s < 4; ++s) Qf[mp][s] = *(const bf16x8*)(Q + (size_t)(qw + (tu_ & 31)) * AW + head * 128 + mp * 64 + 16 * s + 8 * ((tu_ >> 5) & 1));
        const bf16_t* kbase = Kb + head * 128; const bf16_t* vbase = VT + (size_t)head * 128 * SEQ;
#define ATT_GLDS(src, off) __builtin_amdgcn_global_load_lds((const unsigned*)(src), (LAS unsigned*)(lds + (off) + ldsw), 16, 0, 0)
#define ATT_DMA(p, b) do { int td_ = threadIdx.x; asm volatile("" : "+v"(td_));     \
            const int prow = td_ >> 3, pch = (td_ & 7) ^ ((prow >> 1) & 7); const unsigned gK = (unsigned)(prow * AW + pch * 8), gV = (unsigned)(prow * SEQ + pch * 8); \
            _Pragma("unroll") for (int sub = 0; sub < 2; ++sub) { const int k0_ = 128 * (p) + 64 * sub; const unsigned o_ = (unsigned)(b) * 65536u + (unsigned)sub * 32768u; \
            ATT_GLDS(kbase + (size_t)k0_ * AW + gK, o_); ATT_GLDS(kbase + (size_t)k0_ * AW + gK + 64, o_ + 8192u); \
            ATT_GLDS(vbase + gV + k0_, o_ + 16384u); ATT_GLDS(vbase + (size_t)64 * SEQ + gV + k0_, o_ + 24576u); } } while (0)
        ATT_DMA(0, 0);
        asm volatile("s_waitcnt vmcnt(0)" ::: "memory"); __syncthreads();
        f32x16 O1[4], O2[4];
#pragma unroll
        for (int dt = 0; dt < 4; ++dt)
#pragma unroll
            for (int i = 0; i < 16; ++i) { O1[dt][i] = 0.f; O2[dt][i] = 0.f; }
        f32x2_t sum1 = {0.f, 0.f}, sum2 = {0.f, 0.f};
        int pfar = (q0 - 1086 + 63) >> 7; pfar = pfar < 0 ? 0 : pfar;
        const float farscale = __builtin_amdgcn_exp2f(farb);
#define ATT_SB() __builtin_amdgcn_sched_barrier(0)
#define ATT_LDK(mo, s, kt) (*(const LAS bf16x8*)(buf + (mo) + KOFF(s) + (kt) * 4096))
#define ATT_LDV(c, dt) (*(const LAS bf16x8*)(buf + VOFF(c) + (dt) * 4096))
#define ATT_EXP(S, sum, pb) do { _Pragma("unroll") for (int s = 0; s < 2; ++s) { unsigned w[4]; \
            _Pragma("unroll") for (int pp = 0; pp < 4; ++pp) { const int i0 = 8 * s + 2 * pp; \
                const f32x2_t e = {__builtin_amdgcn_exp2f(S[i0]), __builtin_amdgcn_exp2f(S[i0 + 1])}; sum += e; w[pp] = cvt_pk_bf16(e[0], e[1]); } \
            pb[s] = __builtin_bit_cast(bf16x8, ((u32x4){w[0], w[1], w[2], w[3]})); } } while (0)
#define ATT_PV(va, s, d0) do { O1[d0] = MFMA32(va[0], pb1[s], O1[d0]); O2[d0] = MFMA32(va[0], pb2[s], O2[d0]); O1[d0 + 1] = MFMA32(va[1], pb1[s], O1[d0 + 1]); O2[d0 + 1] = MFMA32(va[1], pb2[s], O2[d0 + 1]); } while (0)
#define ATT_SUBTILE(INIT) do { bf16x8 kA[4], vA[2], pb1[2], pb2[2]; \
            _Pragma("unroll") for (int s = 0; s < 4; ++s) kA[s] = ATT_LDK(0, s, 0); \
            ATT_SB(); \
            _Pragma("unroll") for (int kt = 0; kt < 2; ++kt) { \
                f32x16 S; INIT(S); _Pragma("unroll") for (int s = 0; s < 4; ++s) S = MFMA32(kA[s], Qf[0][s], S); \
                ATT_SB(); \
                _Pragma("unroll") for (int s = 0; s < 4; ++s) kA[s] = ATT_LDK(8192, s, kt); \
                ATT_EXP(S, sum1, pb1); \
                ATT_SB(); \
                INIT(S); _Pragma("unroll") for (int s = 0; s < 4; ++s) S = MFMA32(kA[s], Qf[1][s], S); \
                ATT_SB(); \
                vA[0] = ATT_LDV(2 * kt, 0); vA[1] = ATT_LDV(2 * kt, 1); kA[0] = ATT_LDV(2 * kt, 2); kA[1] = ATT_LDV(2 * kt, 3); \
                ATT_EXP(S, sum2, pb2); \
                ATT_SB(); \
                ATT_PV(vA, 0, 0); \
                ATT_SB(); \
                vA[0] = ATT_LDV(2 * kt + 1, 0); vA[1] = ATT_LDV(2 * kt + 1, 1); ATT_PV(kA, 0, 2); \
                ATT_SB(); \
                kA[0] = ATT_LDV(2 * kt + 1, 2); kA[1] = ATT_LDV(2 * kt + 1, 3); ATT_PV(vA, 1, 0); \
                ATT_SB(); \
                ATT_PV(kA, 1, 2); \
                ATT_SB(); \
                if (kt == 0) { _Pragma("unroll") for (int s = 0; s < 4; ++s) kA[s] = ATT_LDK(0, s, 1); ATT_SB(); } } } while (0)
#define ATT_INIT_ZERO(S) do { _Pragma("unroll") for (int i = 0; i < 16; ++i) S[i] = 0.f; } while (0)
#define ATT_INIT_TAB(S) do { const int ib = ib0 - 32 * kt; _Pragma("unroll") for (int i = 0; i < 16; ++i) S[i] = tab[ib - (16 * (i >> 3) + (i & 7))]; } while (0)
        int p = 0;
        for (; p < pfar; ++p) {
            LAS unsigned char* const sbase = lds + (p & 1) * 65536;
#pragma unroll 1
            for (int sub = 0; sub < 2; ++sub) {
                if ((wid >= 4) == (sub == 0)) ATT_DMA(p + 1, (p + 1) & 1);
                LAS unsigned char* buf = sbase + sub * 32768;
                ATT_SUBTILE(ATT_INIT_ZERO);
            }
            asm volatile("s_waitcnt vmcnt(0)" ::: "memory"); __syncthreads();
        }
#pragma unroll
        for (int dt = 0; dt < 4; ++dt) { O1[dt] = O1[dt] * farscale; O2[dt] = O2[dt] * farscale; }
        sum1 = sum1 * farscale; sum2 = sum2 * farscale;
        for (; p < nst; ++p) {
            LAS unsigned char* const sbase = lds + (p & 1) * 65536;
#pragma unroll 1
            for (int sub = 0; sub < 2; ++sub) {
                if (p + 1 < nst && (wid >= 4) == (sub == 0)) ATT_DMA(p + 1, (p + 1) & 1);
                const int stl = 2 * p + sub;
                if (stl <= cw) {
                    LAS unsigned char* buf = sbase + sub * 32768;
                    const int k0 = 64 * stl;
                    const int ib0 = (qw + r) - k0 - 8 * h + 63;
                    ATT_SUBTILE(ATT_INIT_TAB);
                }
            }
            asm volatile("s_waitcnt vmcnt(0)" ::: "memory"); __syncthreads();
        }
#undef ATT_SUBTILE
        float t1 = sum1[0] + sum1[1], t2 = sum2[0] + sum2[1];
        t1 += __shfl_xor(t1, 32); t2 += __shfl_xor(t2, 32);
        const float i1 = 1.f / t1, i2 = lam / t2; float ss = 0.f;
#pragma unroll
        for (int dt = 0; dt < 4; ++dt)
#pragma unroll
            for (int i = 0; i < 16; ++i) { const float o = O1[dt][i] * i1 - O2[dt][i] * i2; O1[dt][i] = o; ss += o * o; }
        ss += __shfl_xor(ss, 32);
        const float rs = rsqrtf(ss * (1.f / 128.f) + EPSF) * 0.8f;
        int te_ = threadIdx.x; asm volatile("" : "+v"(te_)); const int re_ = te_ & 31, he_ = (te_ >> 5) & 1;
        bf16_t* orow = mix + (size_t)(qw + re_) * DM + head * 128;
#pragma unroll
        for (int dt = 0; dt < 4; ++dt)
#pragma unroll
            for (int g4 = 0; g4 < 4; ++g4) { const int d = 32 * dt + 8 * g4 + 4 * he_; const f32x4 gn = *(const f32x4*)(a.in[I_SUBLN] + d);
                u32x2 o; o.x = cvt_pk_bf16(O1[dt][4 * g4] * rs * gn[0], O1[dt][4 * g4 + 1] * rs * gn[1]); o.y = cvt_pk_bf16(O1[dt][4 * g4 + 2] * rs * gn[2], O1[dt][4 * g4 + 3] * rs * gn[3]);
                *(u32x2*)(orow + d) = o; }
    }
#undef ATT_DMA
#undef ATT_GLDS
}

__device__ __forceinline__ void xattn_phase(const Args& a, LAS unsigned char* lds, int G, int bid, int tid) {
    const int wid = __builtin_amdgcn_readfirstlane(tid >> 6), lane = tid & 63, r = lane & 31, h = lane >> 5;
    const bf16_t* XQ = (const bf16_t*)(a.ws + WS_XQ); const float* MKR = (const float*)(a.ws + WS_MKRAW); const bf16_t* MVT = (const bf16_t*)(a.ws + WS_MVT);
    bf16_t* XO = (bf16_t*)(a.ws + WS_XOIN);
    const int rowk = (r & 0x13) | ((r & 4) << 1) | ((r & 8) >> 1);
    const float qsc = 0.08838834764831845f * LOG2E;
    for (int ub = bid; ub < 256; ub += G) {
        const int head = ub & 3, t = ((ub >> 2) * 8 + wid) * 32 + r;
#pragma unroll
        for (int i = 0; i < 8; ++i) { const int piece = wid * 8 + i;
            { const int row = piece * 2 + (lane >> 5), ch = (lane & 31) ^ (row & 15);
              __builtin_amdgcn_global_load_lds((const unsigned*)(MVT + (size_t)(head * 128 + row) * MEML + ch * 8), (LAS unsigned*)(lds + 65536 + piece * 1024), 16, 0, 0); } }
        { const int kc = lane & 15, kr = lane >> 4;
          const f32x4 gk0 = *(const f32x4*)(a.in[I_XK_NORM] + kc * 8), gk1 = *(const f32x4*)(a.in[I_XK_NORM] + kc * 8 + 4);
#pragma unroll 1
          for (int i = 0; i < 2; ++i) { f32x4 k0[4], k1[4];
#pragma unroll
            for (int j = 0; j < 4; ++j) { const float* src = MKR + (size_t)(wid * 32 + i * 16 + j * 4 + kr) * XW + head * 128 + kc * 8; k0[j] = *(const f32x4*)src; k1[j] = *(const f32x4*)(src + 4); }
#pragma unroll
            for (int j = 0; j < 4; ++j) { const int row = wid * 32 + i * 16 + j * 4 + kr;
                const f32x4 t0 = k0[j] * k0[j], t1 = k1[j] * k1[j];
                float ssk = ((t0[0] + t0[1]) + (t0[2] + t0[3])) + ((t1[0] + t1[1]) + (t1[2] + t1[3]));
                ssk += __shfl_xor(ssk, 1); ssk += __shfl_xor(ssk, 2); ssk += __shfl_xor(ssk, 4); ssk += __shfl_xor(ssk, 8);
                const float rk = rsqrtf(ssk * (1.f / 128.f) + EPSF);
                *(LAS u32x4*)(lds + row * 256 + ((kc ^ (row & 15)) << 4)) = pack8(k0[j] * gk0 * rk, k1[j] * gk1 * rk); } } }
        u32x4 qv[8]; float ss = 0.f;
#pragma unroll
        for (int s = 0; s < 8; ++s) { qv[s] = *(const u32x4*)(XQ + (size_t)t * XW + head * 128 + 16 * s + 8 * h);
            const float e0 = bf_lo(qv[s].x), e1 = bf_hi(qv[s].x), e2 = bf_lo(qv[s].y), e3 = bf_hi(qv[s].y), e4 = bf_lo(qv[s].z), e5 = bf_hi(qv[s].z), e6 = bf_lo(qv[s].w), e7 = bf_hi(qv[s].w);
            ss += (e0 * e0 + e1 * e1) + (e2 * e2 + e3 * e3) + (e4 * e4 + e5 * e5) + (e6 * e6 + e7 * e7); }
        ss += __shfl_xor(ss, 32);
        const float rq = rsqrtf(ss * (1.f / 128.f) + EPSF) * qsc;
#pragma unroll
        for (int s = 0; s < 8; ++s) { const f32x4 g0 = *(const f32x4*)(a.in[I_XQ_NORM] + 16 * s + 8 * h), g1 = *(const f32x4*)(a.in[I_XQ_NORM] + 16 * s + 8 * h + 4);
            u32x4 w; w.x = cvt_pk_bf16(bf_lo(qv[s].x) * rq * g0[0], bf_hi(qv[s].x) * rq * g0[1]); w.y = cvt_pk_bf16(bf_lo(qv[s].y) * rq * g0[2], bf_hi(qv[s].y) * rq * g0[3]);
            w.z = cvt_pk_bf16(bf_lo(qv[s].z) * rq * g1[0], bf_hi(qv[s].z) * rq * g1[1]); w.w = cvt_pk_bf16(bf_lo(qv[s].w) * rq * g1[2], bf_hi(qv[s].w) * rq * g1[3]); qv[s] = w; }
        asm volatile("s_waitcnt vmcnt(0)" ::: "memory"); __syncthreads();
        f32x16 O[4];
#pragma unroll
        for (int dt = 0; dt < 4; ++dt)
#pragma unroll
            for (int i = 0; i < 16; ++i) O[dt][i] = 0.f;
        f32x2_t sum = {0.f, 0.f};
#pragma unroll 2
        for (int kt = 0; kt < 8; ++kt) {
            f32x16 sacc;
#pragma unroll
            for (int i = 0; i < 16; ++i) sacc[i] = 0.f;
            const int krow = 32 * kt + rowk;
#pragma unroll
            for (int s = 0; s < 8; ++s) { const bf16x8 ka = *(const LAS bf16x8*)(lds + krow * 256 + (((2 * s + h) ^ (krow & 15)) << 4)); sacc = MFMA32(ka, __builtin_bit_cast(bf16x8, qv[s]), sacc); }
            u32x4 pb[2];
#pragma unroll
            for (int s = 0; s < 2; ++s) { unsigned w[4];
#pragma unroll
                for (int p = 0; p < 4; ++p) { const f32x2_t e = {__builtin_amdgcn_exp2f(sacc[8 * s + 2 * p]), __builtin_amdgcn_exp2f(sacc[8 * s + 2 * p + 1])}; sum += e; w[p] = cvt_pk_bf16(e[0], e[1]); }
                pb[s] = (u32x4){w[0], w[1], w[2], w[3]}; }
#pragma unroll
            for (int dt = 0; dt < 4; ++dt)
#pragma unroll
                for (int s = 0; s < 2; ++s) { const int vrow = 32 * dt + r, c = 4 * kt + 2 * s + h;
                    const bf16x8 va = *(const LAS bf16x8*)(lds + 65536 + vrow * 512 + ((c ^ (vrow & 15)) << 4));
                    O[dt] = MFMA32(va, __builtin_bit_cast(bf16x8, pb[s]), O[dt]); }
        }
        float tot = sum[0] + sum[1]; tot += __shfl_xor(tot, 32);
        const float inv = 1.f / tot;
        bf16_t* orow = XO + (size_t)t * XW + head * 128;
#pragma unroll
        for (int dt = 0; dt < 4; ++dt)
#pragma unroll
            for (int g4 = 0; g4 < 4; ++g4) { u32x2 o; o.x = cvt_pk_bf16(O[dt][4 * g4] * inv, O[dt][4 * g4 + 1] * inv); o.y = cvt_pk_bf16(O[dt][4 * g4 + 2] * inv, O[dt][4 * g4 + 3] * inv);
                *(u32x2*)(orow + 32 * dt + 8 * g4 + 4 * h) = o; }
        __syncthreads();
    }
}

#define XB_TMO      128
#define XB_XCNT(j)  (256  + 64 * (j))
#define XB_XSUB(j)  (1280 + 64 * (j))
#define XB_XGEN(j)  (2304 + 64 * (j))
#define XB_TOP      3328
#define XB_TOPGEN   3392
#define XCD_BAR_WORDS 3456
#define XB_SPIN_CAP (1u << 18)

__device__ __forceinline__ unsigned xb_ld(unsigned* p)              { return __hip_atomic_load(p, __ATOMIC_RELAXED, __HIP_MEMORY_SCOPE_AGENT); }
__device__ __forceinline__ unsigned xb_add(unsigned* p, unsigned v) { return __hip_atomic_fetch_add(p, v, __ATOMIC_RELAXED, __HIP_MEMORY_SCOPE_AGENT); }
__device__ __forceinline__ unsigned xb_xcc_id() { return (unsigned)__builtin_amdgcn_s_getreg((3 << 11) | 20) & 0xFu; }
#define XB_SPIN(cond, bar) do { unsigned _sp = 0; while (cond) { __builtin_amdgcn_s_sleep(1); \
    if ((++_sp & 255u) == 0u) { if (xb_ld(&(bar)[XB_TMO])) break; if (_sp > XB_SPIN_CAP) { atomicAdd(&(bar)[XB_TMO], 1u); break; } } } } while (0)

struct XcdBarrier {
    unsigned* bar; unsigned x;
    volatile LAS unsigned* st;
};

__device__ __forceinline__ XcdBarrier xcd_barrier_post(unsigned* bar, volatile LAS unsigned* st) {
    XcdBarrier b; b.bar = bar; b.x = xb_xcc_id(); b.st = st;
    if (threadIdx.x == 0) (void)xb_add(&bar[XB_XCNT(b.x)], 1u);
    return b;
}
__device__ __forceinline__ void xcd_barrier_complete(unsigned* bar, unsigned x, unsigned& nloc, unsigned& nx) {
    const unsigned G = gridDim.x * gridDim.y * gridDim.z;
    unsigned sum, cnt, mine, sp = 0u;
    for (;;) {
        sum = 0u; cnt = 0u; mine = 0u;
#pragma unroll
        for (unsigned j = 0; j < 16; ++j) { const unsigned c = xb_ld(&bar[XB_XCNT(j)]); sum += c; cnt += (c > 0u) ? 1u : 0u; mine = (j == x) ? c : mine; }
        if (sum == G) break;
        __builtin_amdgcn_s_sleep(1);
        if ((++sp & 255u) == 0u) { if (xb_ld(&bar[XB_TMO])) break; if (sp > XB_SPIN_CAP) { atomicAdd(&bar[XB_TMO], 1u); break; } }
    }
    nloc = mine > 0u ? mine : 1u; nx = cnt > 0u ? cnt : 1u;
}

__device__ __forceinline__ void xcd_barrier(const XcdBarrier& b) {
    asm volatile("s_waitcnt vmcnt(0)" ::: "memory");
    __syncthreads();
    if (threadIdx.x == 0) {
        unsigned* bar = b.bar;
        __builtin_amdgcn_s_waitcnt(0);
        unsigned nloc = b.st[0], nx = b.st[1];
        if (nloc == 0u) { xcd_barrier_complete(bar, b.x, nloc, nx); b.st[0] = nloc; b.st[1] = nx; }
        const unsigned old = xb_add(&bar[XB_XSUB(b.x)], 1u);
        const unsigned gen = old / nloc;
        if (old + 1u == (gen + 1u) * nloc) {
            __builtin_amdgcn_fence(__ATOMIC_RELEASE, "agent");
            asm volatile("s_waitcnt vmcnt(0)" ::: "memory");
            const unsigned og = xb_add(&bar[XB_TOP], 1u);
            const unsigned tg = og / nx;
            if (og + 1u == (tg + 1u) * nx) xb_add(&bar[XB_TOPGEN], 1u);
            else XB_SPIN(xb_ld(&bar[XB_TOPGEN]) == tg, bar);
            __builtin_amdgcn_fence(__ATOMIC_ACQUIRE, "agent");
            xb_add(&bar[XB_XGEN(b.x)], 1u);
            asm volatile("s_waitcnt vmcnt(0)" ::: "memory");
        } else {
            XB_SPIN(xb_ld(&bar[XB_XGEN(b.x)]) == gen, bar);
            __builtin_amdgcn_fence(__ATOMIC_ACQUIRE, "agent");
            asm volatile("s_waitcnt vmcnt(0)" ::: "memory");
        }
    }
    __syncthreads();
}

#ifndef DBG
#define DBG 0
#endif
__device__ __forceinline__ void dbg_dump(const bf16_t* src, float* out, size_t n, int G, int bid, int tid) {
    for (size_t i = (size_t)bid * NTHREADS + tid; i < n; i += (size_t)G * NTHREADS) out[i] = bf_lo((unsigned)src[i]);
}
#define DBG_AT(k, ...) if constexpr (DBG == (k)) { __VA_ARGS__; return; }
__global__ void __launch_bounds__(NTHREADS, 2) fwd_megakernel(Args a) {
    extern __shared__ __attribute__((aligned(16))) unsigned char lds_raw[];
    LAS unsigned char* lds = (LAS unsigned char*)lds_raw;
    cg::grid_group grid = cg::this_grid();
#ifndef PROBE
#define PROBE -1
#endif
#define REP(k) for (int rep_ = 0; rep_ < ((PROBE == (k)) ? 2 : 1); ++rep_)
    volatile LAS unsigned* misc = (volatile LAS unsigned*)(lds + 131072 + 256);
    if (threadIdx.x < 4) misc[threadIdx.x] = 0u;
    __syncthreads();
    XcdBarrier xbar = xcd_barrier_post((unsigned*)(a.ws + WS_BAR), misc);
#define GRID_SYNC() xcd_barrier(xbar)
    const int tid = threadIdx.x, bid = blockIdx.x, G = gridDim.x;
    unsigned char* ws = a.ws;
    typedef bf16_t* BP; typedef float* FP;

#ifndef PHMASK
#define PHMASK 0xFFFFF
#endif
#define PH(k) if constexpr ((PHMASK >> (k)) & 1)
    REP(0) PH(0) { int t_ = tid; asm volatile("" : "+v"(t_)); p0_prologue(a, lds, G, bid, t_); }
    GRID_SYNC();
    if (G == 0x7fffffff) grid.sync();
    REP(1) {
        PH(1) { Gemm g{(BP)(ws + WS_XB), (BP)(ws + WS_WA), SEQ, 4096, DM, DM, DM, 0}; StaticOrder S; S.init(SEQ, 4096, G, bid);
          EpiIn E{(FP)(ws + WS_RSTD1), (BP)(ws + WS_Q), (BP)(ws + WS_K), (BP)(ws + WS_XR), (BP)(ws + WS_YR), a.in[I_QN], a.in[I_KN], 0.125f * LOG2E};
          gemm_phase<EpiIn, StaticOrder, true, true>(lds, g, S, E); }
        __syncthreads();
        PH(2) { Gemm g{(BP)(ws + WS_WV), (BP)(ws + WS_XB), 1024, SEQ, DM, DM, DM, 0}; StaticOrder S; S.init(1024, SEQ, G, bid);
          EpiVT E{(FP)(ws + WS_RSTD1), (BP)(ws + WS_VT)};
          gemm_phase<EpiVT, StaticOrder, true, true>(lds, g, S, E); }
    }
    GRID_SYNC();
    DBG_AT(1, dbg_dump((BP)(ws + WS_Q), a.out, (size_t)SEQ * 2048, G, bid, tid))
    DBG_AT(2, dbg_dump((BP)(ws + WS_VT), a.out, (size_t)SEQ * 2048, G, bid, tid))
    REP(2) { int t_ = tid; asm volatile("" : "+v"(t_)); rnn_front_phase(a, lds, G, bid, t_); }
    GRID_SYNC();
    DBG_AT(3, dbg_dump((BP)(ws + WS_LA), a.out, (size_t)SEQ * 2048, G, bid, tid))
    REP(5) { PH(9) { int t_ = tid; asm volatile("" : "+v"(t_)); scanC_phase(a, lds, G, bid, t_); }
    PH(10) { int t_ = tid; asm volatile("" : "+v"(t_)); attn_phase(a, lds, G, bid, t_); } }
    GRID_SYNC();
    DBG_AT(5, dbg_dump((BP)(ws + WS_MIX), a.out, (size_t)SEQ * 2048, G, bid, tid))
    DBG_AT(7, for (size_t i = (size_t)bid * NTHREADS + tid; i < (size_t)SEQ * 2048; i += (size_t)G * NTHREADS) a.out[i] = (i & 2047) < 1024 ? bf_lo((unsigned)((BP)(ws + WS_MIX))[i]) : 0.f)
    DBG_AT(8, for (size_t i = (size_t)bid * NTHREADS + tid; i < (size_t)SEQ * 2048; i += (size_t)G * NTHREADS) a.out[i] = (i & 2047) >= 1024 ? bf_lo((unsigned)((BP)(ws + WS_MIX))[i]) : 0.f)
    REP(6) PH(11) { Gemm g{(BP)(ws + WS_MIX), (BP)(ws + WS_WOUT), SEQ, DM, DM, DM, DM, 0}; StaticOrder S; S.init(SEQ, DM, G, bid);
      EpiRes<true, true> E{(const void*)(ws + WS_XB), (void*)(ws + WS_XB), (FP)(ws + WS_SSQP2)};
      gemm_phase<EpiRes<true, true>, StaticOrder, true, true>(lds, g, S, E); }
    GRID_SYNC();
    REP(7) PH(12) { Gemm g{(BP)(ws + WS_XB), (BP)(ws + WS_WXQ), SEQ, XW, DM, DM, DM, 0}; StaticOrder S; S.init(SEQ, XW, G, bid);
      EpiPlain<false> E{(void*)(ws + WS_XQ), XW, (FP)(ws + WS_SSQP2)};
      gemm_phase<EpiPlain<false>, StaticOrder, true, true>(lds, g, S, E); }
    __syncthreads();
    { Gemm g{(BP)(ws + WS_MEMN), (BP)(ws + WS_WXK), MEML, XW, DM, DM, DM, 0}; StaticOrder S; S.init(MEML, XW, G, (bid + 128) % G);
      EpiPlain<true> E{(void*)(ws + WS_MKRAW), XW, nullptr};
      gemm_phase<EpiPlain<true>, StaticOrder, true, true>(lds, g, S, E); }
    __syncthreads();
    { Gemm g{(BP)(ws + WS_WXV), (BP)(ws + WS_MEMN), XW, MEML, DM, DM, DM, 0}; StaticOrder S; S.init(XW, MEML, G, (bid + 126) % G);
      EpiPlain<false> E{(void*)(ws + WS_MVT), MEML, nullptr};
      gemm_phase<EpiPlain<false>, StaticOrder, true, true>(lds, g, S, E); }
    __syncthreads();
    { const int first_idle = (SEQ / 256) * (XW / 256) + 4;
      if (G > first_idle + 16) { if (bid >= first_idle) { int t_ = tid; asm volatile("" : "+v"(t_)); wdn_convert(a, lds, G - first_idle, bid - first_idle, t_); } }
      else { int t_ = tid; asm volatile("" : "+v"(t_)); wdn_convert(a, lds, G, bid, t_); } }
    GRID_SYNC();
    REP(8) PH(13) { int t_ = tid; asm volatile("" : "+v"(t_)); xattn_phase(a, lds, G, bid, t_); }
    GRID_SYNC();
    PH(14) { Gemm g{(BP)(ws + WS_XOIN), (BP)(ws + WS_WXO), SEQ, DM, XW, XW, XW, 0}; StaticOrder S; S.init(SEQ, DM, G, bid);
      EpiRes<true, true> E{(const void*)(ws + WS_XB), (void*)(ws + WS_XB), (FP)(ws + WS_SSQP3)};
      gemm_phase<EpiRes<true, true>, StaticOrder, true, true>(lds, g, S, E); }
    GRID_SYNC();
    REP(10) PH(15) { Gemm g{(BP)(ws + WS_XB), (BP)(ws + WS_WGU), SEQ, 2 * DFF, DM, DM, DM, 0}; StaticOrder S; S.init(SEQ, 2 * DFF, G, bid);
      EpiGU E{(FP)(ws + WS_SSQP3), (BP)(ws + WS_HID)};
      gemm_phase<EpiGU, StaticOrder, true, true>(lds, g, S, E); }
    GRID_SYNC();
    PH(16) { Gemm g{(BP)(ws + WS_HID), (BP)(ws + WS_WDN), SEQ, DM, DFF, DFF, DFF, 0}; StaticOrder S; S.init(SEQ, DM, G, bid);
      EpiRes<true, false> E{(const void*)(ws + WS_XB), (void*)a.out, nullptr};
      gemm_phase<EpiRes<true, false>, StaticOrder, true, true>(lds, g, S, E); }
}

extern "C" void kernel_launch(void* const* d_in, const int* in_sizes, int n_in, void* d_out, int out_size, void* d_ws, size_t ws_size, hipStream_t stream) {
    static int grid = 0;
    if (grid == 0) {
        if (n_in != 32 || ws_size < WS_END) { fprintf(stderr, "kernel_launch: unexpected problem (n_in %d, ws %zu)\n", n_in, ws_size); grid = -1; return; }
        int dev = 0, cus = 0, per_cu = 0;
        hipGetDevice(&dev); hipDeviceGetAttribute(&cus, hipDeviceAttributeMultiprocessorCount, dev);
        if (hipFuncSetAttribute((const void*)fwd_megakernel, hipFuncAttributeMaxDynamicSharedMemorySize, LDS_BYTES) != hipSuccess) { fprintf(stderr, "kernel_launch: hipFuncSetAttribute failed\n"); grid = -1; return; }
        hipOccupancyMaxActiveBlocksPerMultiprocessor(&per_cu, (const void*)fwd_megakernel, NTHREADS, LDS_BYTES);
        if (per_cu < 1) { fprintf(stderr, "kernel_launch: occupancy query says %d blocks per CU\n", per_cu); per_cu = 1; }
        (void)hipGetLastError();
        grid = cus * per_cu;
    }
    if (grid < 0) return;
    if (hipMemsetAsync((char*)d_ws + WS_BAR, 0, 16 * KiB, stream) != hipSuccess) { fprintf(stderr, "kernel_launch: hipMemsetAsync failed\n"); return; }
    Args a{};
    for (int i = 0; i < 32; ++i) a.in[i] = (const float*)d_in[i];
    a.out = (float*)d_out; a.ws = (unsigned char*)d_ws;
    void* args[] = {&a};
    hipError_t e = hipLaunchCooperativeKernel((const void*)fwd_megakernel, dim3(grid), dim3(NTHREADS), args, LDS_BYTES, stream);
    if (e != hipSuccess) fprintf(stderr, "cooperative launch failed: %s (grid %d)\n", hipGetErrorString(e), grid);
}
```

```cpp
#include <hip/hip_runtime.h>
#include <hip/hip_cooperative_groups.h>
#include <cstdio>
#include <cstdint>
namespace cg = cooperative_groups;
#define LAS __attribute__((address_space(3)))
namespace pg8 {
#define PG8_LAS __attribute__((address_space(3)))
typedef unsigned short bf16_t;
typedef short bf16x8 __attribute__((ext_vector_type(8)));
typedef float f32x4 __attribute__((ext_vector_type(4)));
typedef unsigned u32x4 __attribute__((ext_vector_type(4)));
constexpr int BM = 256, BK = 64, HALF = 128, HTB = HALF * BK * 2  , STAGE_BYTES = 8 * HTB, NXCD = 8, WGM = 4;

__host__ __device__ __forceinline__ int lds_byte(int r, int c) { const int st = (r >> 4) * 2 + (c >> 5), rr = r & 15, cc = c & 31, ob = rr * 64 + cc * 2; return st * 1024 + (ob ^ (((ob >> 9) & 1) << 5)); }
__host__ __device__ __forceinline__ void stage_rc(int b, int& R, int& C) { const int st = b / 1024, sb = b % 1024, swz = sb ^ (((sb >> 9) & 1) << 5); R = (st >> 1) * 16 + swz / 64; C = (st & 1) * 32 + (swz % 64) / 2; }
__host__ __device__ __forceinline__ int perm32(int rho) { const int n = rho >> 4, i = rho & 15; return 8 * (i >> 2) + 4 * n + (i & 3); }

struct Unit { int pm, pn; };
struct Gemm { const bf16_t* A; const bf16_t* Bt; int M, N, K, lda, ldb; long apn; };

struct StaticOrder {
    int nM, nN, nwg, G, c;
    __host__ __device__ void init(int M, int N, int G_, int c_) { nM = M / BM; nN = N / BM; nwg = nM * nN; G = G_; c = c_; }
    __host__ __device__ bool next(int i, Unit& u) const {
        const long L = (long)i * G + c; if (L >= nwg) return false;
        int wgid = (int)L; { const int q = nwg / NXCD, r = nwg % NXCD, xcd = wgid % NXCD, off = wgid / NXCD; wgid = (xcd < r ? xcd * (q + 1) : r * (q + 1) + (xcd - r) * q) + off; }
        const int nig = WGM * nN, gid = wgid / nig, fm = gid * WGM, gsz = (nM - fm) < WGM ? (nM - fm) : WGM;
        u.pm = fm + ((wgid % nig) % gsz); u.pn = (wgid % nig) / gsz; return true;
    }
    __device__ __forceinline__ void a_ready(const Unit&) const {}
    __device__ __forceinline__ void done(const Unit&) const {}
};

typedef unsigned u32x2 __attribute__((ext_vector_type(2)));
typedef float f32x16 __attribute__((ext_vector_type(16)));
typedef __bf16 bf16x2_t __attribute__((ext_vector_type(2)));
typedef float f32x2_t __attribute__((ext_vector_type(2)));
__device__ __forceinline__ unsigned cvt_pk_bf16(float lo, float hi) { const f32x2_t v = {lo, hi}; const bf16x2_t b = __builtin_convertvector(v, bf16x2_t); return __builtin_bit_cast(unsigned, b); }
__device__ __forceinline__ u32x4 pack8(const f32x4 a, const f32x4 b) { u32x4 w; w.x = cvt_pk_bf16(a[0], a[1]); w.y = cvt_pk_bf16(a[2], a[3]); w.z = cvt_pk_bf16(b[0], b[1]); w.w = cvt_pk_bf16(b[2], b[3]); return w; }
__device__ __forceinline__ float bf_lo(unsigned w) { return __uint_as_float(w << 16); }
__device__ __forceinline__ float bf_hi(unsigned w) { return __uint_as_float(w & 0xffff0000u); }
constexpr float EPSF = 1e-6f, LOG2E = 1.4426950408889634f;

struct EpiIn {
    static constexpr bool PERM = true, AFTER_DRAIN = false;
    const float* rstd; bf16_t *q, *k, *xr, *yr; const float *qg, *kg; float qscale;
    __device__ __forceinline__ void operator()(const f32x4 (&acc)[2][2][4][2], const Unit& u, int wr, int wc, int fr, int fq) const {
        const int region = u.pn >> 2;
        const int lc0 = (u.pn & 3) * 256 + wc * 64 + fq * 8;
        bf16_t* dst = q + (size_t)region * (16u << 20) + (region >= 2 ? (size_t)(16u << 20) : (size_t)0);
        const bool nrm = region < 2;
        f32x4 g[2][2];
#pragma unroll
        for (int bj = 0; bj < 2; ++bj)
#pragma unroll
            for (int n = 0; n < 2; ++n) g[bj][n] = (f32x4){1.f, 1.f, 1.f, 1.f};
        if (nrm) { const float* gp = region == 0 ? qg : kg; const float sc = region == 0 ? qscale : 1.f;
#pragma unroll
            for (int bj = 0; bj < 2; ++bj)
#pragma unroll
                for (int n = 0; n < 2; ++n) g[bj][n] = *(const f32x4*)(gp + 32 * bj + fq * 8 + 4 * n) * sc; }
#pragma unroll
        for (int ai = 0; ai < 2; ++ai)
#pragma unroll
            for (int m = 0; m < 4; ++m) {
                const int row = u.pm * BM + ai * HALF + wr * 64 + m * 16 + fr; const float rs = rstd[row];
                f32x4 v[2][2]; float ss = 0.f;
#pragma unroll
                for (int bj = 0; bj < 2; ++bj)
#pragma unroll
                    for (int n = 0; n < 2; ++n) { v[bj][n] = acc[ai][bj][m][n] * rs; const f32x4 t = v[bj][n] * v[bj][n]; ss += (t[0] + t[1]) + (t[2] + t[3]); }
                float r = 1.f;
                if (nrm) { ss += __shfl_xor(ss, 16); ss += __shfl_xor(ss, 32); r = rsqrtf(ss * (1.f / 64.f) + EPSF); }
#pragma unroll
                for (int bj = 0; bj < 2; ++bj) { const u32x4 w = pack8(v[bj][0] * g[bj][0] * r, v[bj][1] * g[bj][1] * r);
                    *(u32x4*)(dst + (size_t)row * 1024 + lc0 + 32 * bj) = w; }
            }
    }
};
struct EpiVT {
    static constexpr bool PERM = true, AFTER_DRAIN = false;
    const float* rstd; bf16_t* vT;
    __device__ __forceinline__ void operator()(const f32x4 (&acc)[2][2][4][2], const Unit& u, int wr, int wc, int fr, int fq) const {
        f32x4 rs[2][2];
#pragma unroll
        for (int bj = 0; bj < 2; ++bj)
#pragma unroll
            for (int n = 0; n < 2; ++n) rs[bj][n] = *(const f32x4*)(rstd + u.pn * BM + bj * HALF + wc * 32 + fq * 8 + 4 * n);
#pragma unroll
        for (int ai = 0; ai < 2; ++ai)
#pragma unroll
            for (int m = 0; m < 4; ++m) { const int row = u.pm * BM + ai * HALF + wr * 64 + m * 16 + fr;
#pragma unroll
                for (int bj = 0; bj < 2; ++bj) *(u32x4*)(vT + (size_t)row * 16384 + u.pn * BM + bj * HALF + wc * 32 + fq * 8) = pack8(acc[ai][bj][m][0] * rs[bj][0], acc[ai][bj][m][1] * rs[bj][1]); }
    }
};
__device__ __forceinline__ float row_rstd32(const float* ssqp, int row, int fq) {
    const f32x4 a = *(const f32x4*)(ssqp + ((size_t)(2 * fq) * 16384 + row) * 4), b = *(const f32x4*)(ssqp + ((size_t)(2 * fq + 1) * 16384 + row) * 4);
    float s = ((a[0] + a[1]) + (a[2] + a[3])) + ((b[0] + b[1]) + (b[2] + b[3]));
    s += __shfl_xor(s, 16); s += __shfl_xor(s, 32);
    return rsqrtf(s * (1.f / 2048.f) + EPSF);
}
template <bool F32OUT> struct EpiPlain {
    static constexpr bool PERM = true, AFTER_DRAIN = false;
    void* out; int ldc; const float* ssq;
    __device__ __forceinline__ void operator()(const f32x4 (&acc)[2][2][4][2], const Unit& u, int wr, int wc, int fr, int fq) const {
#pragma unroll
        for (int ai = 0; ai < 2; ++ai)
#pragma unroll
            for (int m = 0; m < 4; ++m) { const int row = u.pm * BM + ai * HALF + wr * 64 + m * 16 + fr;
                const float rs = ssq ? row_rstd32(ssq, row, fq) : 1.f;
#pragma unroll
                for (int bj = 0; bj < 2; ++bj) { const size_t off = (size_t)row * ldc + u.pn * BM + bj * HALF + wc * 32 + fq * 8;
                    if (F32OUT) { *(f32x4*)((float*)out + off) = acc[ai][bj][m][0] * rs; *(f32x4*)((float*)out + off + 4) = acc[ai][bj][m][1] * rs; }
                    else *(u32x4*)((bf16_t*)out + off) = pack8(acc[ai][bj][m][0] * rs, acc[ai][bj][m][1] * rs); } }
    }
};
template <bool BASE_BF16, bool OUT_BF16> struct EpiRes {
    static constexpr bool PERM = true, AFTER_DRAIN = false;
    const void* base; void* out; float* ssq;
    __device__ __forceinline__ void operator()(const f32x4 (&acc)[2][2][4][2], const Unit& u, int wr, int wc, int fr, int fq) const {
#pragma unroll
        for (int ai = 0; ai < 2; ++ai)
#pragma unroll
            for (int m = 0; m < 4; ++m) { const int row = u.pm * BM + ai * HALF + wr * 64 + m * 16 + fr; float ss = 0.f;
#pragma unroll
                for (int bj = 0; bj < 2; ++bj) { const size_t off = (size_t)row * 2048 + u.pn * BM + bj * HALF + wc * 32 + fq * 8;
                    f32x4 b0, b1;
                    if (BASE_BF16) { const u32x4 w = *(const u32x4*)((const bf16_t*)base + off); b0 = (f32x4){bf_lo(w.x), bf_hi(w.x), bf_lo(w.y), bf_hi(w.y)}; b1 = (f32x4){bf_lo(w.z), bf_hi(w.z), bf_lo(w.w), bf_hi(w.w)}; }
                    else { b0 = *(const f32x4*)((const float*)base + off); b1 = *(const f32x4*)((const float*)base + off + 4); }
                    const f32x4 v0 = b0 + acc[ai][bj][m][0], v1 = b1 + acc[ai][bj][m][1];
                    if (OUT_BF16) *(u32x4*)((bf16_t*)out + off) = pack8(v0, v1);
                    else { *(f32x4*)((float*)out + off) = v0; *(f32x4*)((float*)out + off + 4) = v1; }
                    const f32x4 t0 = v0 * v0, t1 = v1 * v1; ss += ((t0[0] + t0[1]) + (t0[2] + t0[3])) + ((t1[0] + t1[1]) + (t1[2] + t1[3])); }
                if (ssq) { ss += __shfl_xor(ss, 16); ss += __shfl_xor(ss, 32); if (fq == 0) ssq[((size_t)u.pn * 16384 + row) * 4 + wc] = ss; }
            }
    }
};
struct EpiGU {
    static constexpr bool PERM = true, AFTER_DRAIN = false;
    const float* ssq; bf16_t* hid;
    __device__ __forceinline__ void operator()(const f32x4 (&acc)[2][2][4][2], const Unit& u, int wr, int wc, int fr, int fq) const {
#pragma unroll
        for (int ai = 0; ai < 2; ++ai)
#pragma unroll
            for (int m = 0; m < 4; ++m) { const int row = u.pm * BM + ai * HALF + wr * 64 + m * 16 + fr;
                const float rs = row_rstd32(ssq, row, fq);
                f32x4 hv[2];
#pragma unroll
                for (int n = 0; n < 2; ++n) { const f32x4 gg = acc[ai][0][m][n] * rs, uu = acc[ai][1][m][n] * rs;
#pragma unroll
                    for (int e = 0; e < 4; ++e) hv[n][e] = gg[e] * __builtin_amdgcn_rcpf(1.f + __builtin_amdgcn_exp2f(-gg[e] * LOG2E)) * uu[e]; }
                *(u32x4*)(hid + (size_t)row * 5632 + u.pn * 128 + wc * 32 + fq * 8) = pack8(hv[0], hv[1]); }
    }
};
struct EpiGate {
    static constexpr bool PERM = true, AFTER_DRAIN = false;
    const bf16_t* xc; const float *ga_b, *gx_b, *spl; bf16_t *la, *uo;
    __device__ __forceinline__ void operator()(const f32x4 (&acc)[2][2][4][2], const Unit& u, int wr, int wc, int fr, int fq) const {
        const int c0 = u.pn * 128 + wc * 32 + fq * 8;
#pragma unroll
        for (int n = 0; n < 2; ++n) {
            const f32x4 ba = *(const f32x4*)(ga_b + c0 + 4 * n), bx = *(const f32x4*)(gx_b + c0 + 4 * n), sp = *(const f32x4*)(spl + c0 + 4 * n);
            u32x2 xws[2][4];
#pragma unroll
            for (int ai = 0; ai < 2; ++ai)
#pragma unroll
                for (int m = 0; m < 4; ++m) xws[ai][m] = *(const u32x2*)(xc + (size_t)(u.pm * BM + ai * HALF + wr * 64 + m * 16 + fr) * 1024 + c0 + 4 * n);
#pragma unroll
            for (int ai = 0; ai < 2; ++ai)
#pragma unroll
                for (int m = 0; m < 4; ++m) { const int row = u.pm * BM + ai * HALF + wr * 64 + m * 16 + fr;
                    const u32x2 xw = xws[ai][m];
                    const f32x4 xv = (f32x4){bf_lo(xw.x), bf_hi(xw.x), bf_lo(xw.y), bf_hi(xw.y)};
                    const f32x4 pa = acc[ai][0][m][n] + ba, px = acc[ai][1][m][n] + bx;
                    f32x4 lv, uv;
#pragma unroll
                    for (int e = 0; e < 4; ++e) {
                        const float ga = __builtin_amdgcn_rcpf(1.f + __builtin_amdgcn_exp2f(-pa[e] * LOG2E));
                        const float gx = __builtin_amdgcn_rcpf(1.f + __builtin_amdgcn_exp2f(-px[e] * LOG2E));
                        const float l2 = -ga * sp[e];
                        const float xl = 2.f * l2 * 0.6931471805599453f;
                        const float om = xl > -0.02f ? -(xl + xl * xl * (0.5f + xl * (1.f / 6.f))) : 1.f - __builtin_amdgcn_exp2f(2.f * l2);
                        lv[e] = l2; uv[e] = xv[e] * gx * __builtin_amdgcn_sqrtf(om); }
                    u32x2 lo, uo2; lo.x = cvt_pk_bf16(lv[0], lv[1]); lo.y = cvt_pk_bf16(lv[2], lv[3]); uo2.x = cvt_pk_bf16(uv[0], uv[1]); uo2.y = cvt_pk_bf16(uv[2], uv[3]);
                    *(u32x2*)(la + (size_t)row * 1024 + c0 + 4 * n) = lo;
                    *(u32x2*)(uo + (size_t)row * 1024 + c0 + 4 * n) = uo2; }
            asm volatile("" ::: "memory");
        }
    }
};

template <class Epi, class Sched, bool ALIGN_EPI = false, bool SP2 = false>
__device__ __forceinline__ void gemm_phase(PG8_LAS unsigned char* lds, const Gemm g, const Sched& S, const Epi& E) {
    int tid_ = threadIdx.x; asm volatile("" : "+v"(tid_));
    const int tid = tid_, wid = __builtin_amdgcn_readfirstlane(tid >> 6), lane = tid & 63, wr = wid >> 2, wc = wid & 3, fr = lane & 15, fq = lane >> 4;
    const int K = g.K, nt = K / BK;
    unsigned voffA[2], voffB[2];
#pragma unroll
    for (int i = 0; i < 2; ++i) { int R, C; stage_rc(tid * 16 + i * 8192, R, C); const int Rb = Epi::PERM ? ((R & ~31) + perm32(R & 31)) : R;
        voffA[i] = (unsigned)(R * g.lda + C) * 2u; voffB[i] = (unsigned)(Rb * g.ldb + C) * 2u; }
    const size_t kstep = (size_t)(BK * 2);
    const size_t hstepA = (size_t)HALF * g.lda * 2, hstepB = (size_t)HALF * g.ldb * 2;
    const size_t tstepA = 2 * hstepA, tstepB = 2 * hstepB, apnb = (size_t)g.apn * 2;
    const unsigned ldsw = (unsigned)wid * 1024u;
    const int aoff = lds_byte(wr * 64 + fr, fq * 8), boff = lds_byte(wc * 32 + fr, fq * 8);
#define PG8_SA(b, h) (((b) * 2 + (h)) * HTB)
#define PG8_SB(b, h) ((4 + (b) * 2 + (h)) * HTB)
#define PG8_STAGE(bufoff, gbase, voff) do { _Pragma("unroll") for (int _i = 0; _i < 2; ++_i) \
        __builtin_amdgcn_global_load_lds((const unsigned*)((const char*)(gbase) + (voff)[_i]), (PG8_LAS unsigned*)(lds + (bufoff) + ldsw + _i * 8192), 16, 0, 0); } while (0)
#define PG8_LDA(dst, b, h) do { _Pragma("unroll") for (int m = 0; m < 4; ++m) _Pragma("unroll") for (int k = 0; k < 2; ++k) dst[m][k] = *(const PG8_LAS bf16x8*)(lds + PG8_SA(b, h) + aoff + m * 2048 + k * 1024); } while (0)
#define PG8_LDB(dst, b, h) do { _Pragma("unroll") for (int n = 0; n < 2; ++n) _Pragma("unroll") for (int k = 0; k < 2; ++k) dst[n][k] = *(const PG8_LAS bf16x8*)(lds + PG8_SB(b, h) + boff + n * 2048 + k * 1024); } while (0)
#define PG8_MMA(ai, bj, At, Bt) do { __builtin_amdgcn_s_setprio(1); _Pragma("unroll") for (int m = 0; m < 4; ++m) _Pragma("unroll") for (int n = 0; n < 2; ++n) _Pragma("unroll") for (int k = 0; k < 2; ++k) \
        acc[ai][bj][m][n] = __builtin_amdgcn_mfma_f32_16x16x32_bf16(Bt[n][k], At[m][k], acc[ai][bj][m][n], 0, 0, 0); __builtin_amdgcn_s_setprio(0); } while (0)
#define PG8_WAIT_V(n) asm volatile("s_waitcnt vmcnt(" #n ")" ::: "memory")
#define PG8_WAIT_L(n) asm volatile("s_waitcnt lgkmcnt(" #n ")" ::: "memory")
#define PG8_BAR __builtin_amdgcn_s_barrier()
#define PG8_SCHED __builtin_amdgcn_sched_barrier(0)
    Unit cur, nxt; int ui = 0;
    if (!S.next(0, cur)) return;
    f32x4 acc[2][2][4][2];
#pragma unroll
    for (int a = 0; a < 2; ++a)
#pragma unroll
        for (int b = 0; b < 2; ++b)
#pragma unroll
            for (int m = 0; m < 4; ++m)
#pragma unroll
                for (int n = 0; n < 2; ++n) acc[a][b][m][n] = (f32x4){0.f, 0.f, 0.f, 0.f};
    bf16x8 At[4][2], B0[2][2], B1[2][2];
    const char* cA = (const char*)g.A + (size_t)cur.pm * tstepA + (size_t)cur.pn * apnb; const char* cB = (const char*)g.Bt + (size_t)cur.pn * tstepB;
    S.a_ready(cur);
    if constexpr (SP2) {
        PG8_STAGE(PG8_SB(0, 0), cB, voffB); PG8_STAGE(PG8_SB(0, 1), cB + hstepB, voffB); PG8_STAGE(PG8_SA(0, 0), cA, voffA); PG8_STAGE(PG8_SA(0, 1), cA + hstepA, voffA);
        if (wr == 1) PG8_BAR;
        PG8_WAIT_V(2); PG8_BAR;
        PG8_STAGE(PG8_SB(1, 0), cB + kstep, voffB); PG8_STAGE(PG8_SA(1, 0), cA + kstep, voffA); PG8_STAGE(PG8_SB(1, 1), cB + hstepB + kstep, voffB);
        PG8_WAIT_V(6); PG8_BAR;
    } else {
        PG8_STAGE(PG8_SB(0, 0), cB, voffB); PG8_STAGE(PG8_SA(0, 0), cA, voffA); PG8_STAGE(PG8_SB(0, 1), cB + hstepB, voffB); PG8_STAGE(PG8_SA(0, 1), cA + hstepA, voffA);
        if (wr == 1) PG8_BAR;
        PG8_WAIT_V(4); PG8_BAR;
        PG8_STAGE(PG8_SB(1, 0), cB + kstep, voffB); PG8_STAGE(PG8_SA(1, 0), cA + kstep, voffA); PG8_STAGE(PG8_SB(1, 1), cB + hstepB + kstep, voffB);
        PG8_WAIT_V(6); PG8_BAR;
    }
    for (;;) {
        const bool has_next = S.next(ui + 1, nxt);
        const char* nA = has_next ? (const char*)g.A + (size_t)nxt.pm * tstepA + (size_t)nxt.pn * apnb : cA; const char* nB = has_next ? (const char*)g.Bt + (size_t)nxt.pn * tstepB : cB;
        for (int t = 0; t < nt; t += 2) {
            const bool last = (t == nt - 2);
            const char* a1 = cA + (size_t)(t + 1) * kstep;
            const char* a2 = last ? nA : cA + (size_t)(t + 2) * kstep; const char* b2 = last ? nB : cB + (size_t)(t + 2) * kstep;
            const char* a3 = a2 + kstep; const char* b3 = b2 + kstep;
            if (last && has_next) S.a_ready(nxt);
            if constexpr (SP2) {
            PG8_LDB(B0, 0, 0); PG8_LDB(B1, 0, 1); PG8_SCHED; PG8_LDA(At, 0, 0); PG8_STAGE(PG8_SA(1, 1), a1 + hstepA, voffA);
            PG8_WAIT_V(8); PG8_WAIT_L(0); PG8_BAR; PG8_MMA(0, 0, At, B0); PG8_MMA(0, 1, At, B1); PG8_BAR; PG8_SCHED;
            PG8_LDA(At, 0, 1); PG8_STAGE(PG8_SB(0, 0), b2, voffB); PG8_STAGE(PG8_SB(0, 1), b2 + hstepB, voffB); PG8_STAGE(PG8_SA(0, 0), a2, voffA);
            PG8_WAIT_V(8); PG8_WAIT_L(0); PG8_BAR; PG8_MMA(1, 0, At, B0); PG8_MMA(1, 1, At, B1); PG8_BAR; PG8_SCHED;
            PG8_LDB(B0, 1, 0); PG8_LDB(B1, 1, 1); PG8_SCHED; PG8_LDA(At, 1, 0); PG8_STAGE(PG8_SA(0, 1), a2 + hstepA, voffA);
            PG8_WAIT_V(8); PG8_WAIT_L(0); PG8_BAR; PG8_MMA(0, 0, At, B0); PG8_MMA(0, 1, At, B1); PG8_BAR; PG8_SCHED;
            PG8_LDA(At, 1, 1); PG8_STAGE(PG8_SB(1, 0), b3, voffB); PG8_STAGE(PG8_SB(1, 1), b3 + hstepB, voffB); PG8_STAGE(PG8_SA(1, 0), a3, voffA);
            PG8_WAIT_V(8); PG8_WAIT_L(0); PG8_BAR; PG8_MMA(1, 0, At, B0); PG8_MMA(1, 1, At, B1); PG8_BAR; PG8_SCHED;
            } else {
            PG8_LDB(B0, 0, 0); PG8_SCHED; PG8_LDA(At, 0, 0); PG8_STAGE(PG8_SA(1, 1), a1 + hstepA, voffA);
            PG8_WAIT_L(8); PG8_BAR; PG8_WAIT_L(0); PG8_MMA(0, 0, At, B0); PG8_BAR; PG8_SCHED;
            PG8_LDB(B1, 0, 1); PG8_STAGE(PG8_SB(0, 0), b2, voffB);
            PG8_BAR; PG8_WAIT_L(0); PG8_MMA(0, 1, At, B1); PG8_BAR;
            PG8_LDA(At, 0, 1); PG8_STAGE(PG8_SA(0, 0), a2, voffA);
            PG8_BAR; PG8_WAIT_L(0); PG8_MMA(1, 0, At, B0); PG8_BAR; PG8_SCHED;
            PG8_STAGE(PG8_SB(0, 1), b2 + hstepB, voffB);
            PG8_WAIT_V(6); PG8_BAR; PG8_MMA(1, 1, At, B1); PG8_BAR;
            PG8_LDB(B0, 1, 0); PG8_SCHED; PG8_LDA(At, 1, 0); PG8_STAGE(PG8_SA(0, 1), a2 + hstepA, voffA);
            PG8_WAIT_L(8); PG8_BAR; PG8_WAIT_L(0); PG8_MMA(0, 0, At, B0); PG8_BAR; PG8_SCHED;
            PG8_LDB(B1, 1, 1); PG8_STAGE(PG8_SB(1, 0), b3, voffB);
            PG8_BAR; PG8_WAIT_L(0); PG8_MMA(0, 1, At, B1); PG8_BAR;
            PG8_LDA(At, 1, 1); PG8_STAGE(PG8_SA(1, 0), a3, voffA);
            PG8_BAR; PG8_WAIT_L(0); PG8_MMA(1, 0, At, B0); PG8_BAR; PG8_SCHED;
            PG8_STAGE(PG8_SB(1, 1), b3 + hstepB, voffB);
            PG8_WAIT_V(6); PG8_BAR; PG8_MMA(1, 1, At, B1); PG8_BAR;
            }
        }
        if constexpr (ALIGN_EPI) { if (wr == 0) PG8_BAR; }
        if constexpr (!Epi::AFTER_DRAIN) { E(acc, cur, wr, wc, fr, fq); S.done(cur); }
        if (!has_next) break;
#pragma unroll
        for (int a = 0; a < 2; ++a)
#pragma unroll
            for (int b = 0; b < 2; ++b)
#pragma unroll
                for (int m = 0; m < 4; ++m)
#pragma unroll
                    for (int n = 0; n < 2; ++n) acc[a][b][m][n] = (f32x4){0.f, 0.f, 0.f, 0.f};
        cur = nxt; cA = nA; cB = nB; ++ui;
        if constexpr (ALIGN_EPI) { if (wr == 1) PG8_BAR; }
    }
    PG8_WAIT_V(0);
    if constexpr (!ALIGN_EPI) { if (wr == 0) PG8_BAR; }
    PG8_BAR;
    if constexpr (Epi::AFTER_DRAIN) { E.fused(acc, cur, wr, wc, fr, fq, lds, wid, lane); S.done(cur); }
#undef PG8_SA
#undef PG8_SB
#undef PG8_STAGE
#undef PG8_LDA
#undef PG8_LDB
#undef PG8_MMA
#undef PG8_WAIT_V
#undef PG8_WAIT_L
#undef PG8_BAR
#undef PG8_SCHED
}
}
using namespace pg8;
#define GLOBAL_AS __attribute__((address_space(1)))
constexpr int SEQ = 16384, DM = 2048, AW = 1024, RW = 1024, INW = 5120, XW = 512, DFF = 5632, MEML = 256;
constexpr int NTHREADS = 512, NWAVES = 8;
constexpr int LDS_BYTES = 147456;
constexpr size_t KiB = 1024, MiB = 1u << 20;
constexpr size_t WS_RSTD1 = 0, WS_SSQ2 = 64 * KiB, WS_SSQ3 = 128 * KiB, WS_SPL = 192 * KiB, WS_BAR = 208 * KiB  , WS_MKRAW = 256 * KiB, WS_MKN = 768 * KiB, WS_MVT = 1 * MiB;
constexpr size_t WS_MEMN = 2 * MiB, WS_AS = 3 * MiB, WS_HEND = 4 * MiB, WS_WGATE = 5 * MiB, WS_WA = 6 * MiB, WS_WV = 22 * MiB, WS_WOUT = 26 * MiB;
constexpr size_t WS_WXQ = 34 * MiB, WS_WXK = 36 * MiB, WS_WXV = 38 * MiB, WS_WXO = 40 * MiB, WS_WGU = 42 * MiB, WS_WDN = 86 * MiB, WS_XB = 108 * MiB;
constexpr size_t WS_Q = 172 * MiB, WS_K = 204 * MiB, WS_VT = 236 * MiB, WS_XR = 268 * MiB, WS_YR = 300 * MiB, WS_XC = 332 * MiB, WS_HID = 172 * MiB;
constexpr size_t WS_LA = 364 * MiB, WS_U = 396 * MiB, WS_MIX = 428 * MiB, WS_XQ = 364 * MiB, WS_XOIN = 380 * MiB, WS_SSQP2 = 492 * MiB, WS_SSQP3 = 494 * MiB, WS_END = 496 * MiB;

struct Args { const float* in[32]; float* out; unsigned char* ws; };
enum { I_X = 0, I_MEM, I_RELB, I_ATTN_NORM, I_W_IN, I_QN, I_KN, I_LQ1, I_LK1, I_LQ2, I_LK2, I_SUBLN, I_CONV_W, I_CONV_B, I_GA_W, I_GA_B, I_GX_W, I_GX_B,
       I_RGL, I_RNN_NORM, I_W_OUT, I_XATTN_NORM, I_MEM_NORM, I_XQ_W, I_XK_W, I_XV_W, I_XQ_NORM, I_XK_NORM, I_XO_W, I_FFN_NORM, I_W_GU, I_W_DN };

__device__ __forceinline__ float wave_sum(float v) {
#pragma unroll
    for (int o = 1; o < 64; o <<= 1) v += __shfl_xor(v, o);
    return v;
}
#define LDS_WAIT() asm volatile("s_waitcnt lgkmcnt(0)" ::: "memory")

__device__ __forceinline__ void xpose_item(const float* W, int ldw, int csrc, const float* gain, bf16_t* WT, int ldt, int drow, int k0, LAS float* scr, int lane) {
    f32x4 wv[8];
#pragma unroll
    for (int i = 0; i < 8; ++i) wv[i] = __builtin_nontemporal_load((const f32x4*)(W + (size_t)(k0 + 8 * i + (lane >> 3)) * ldw + csrc + (lane & 7) * 4));
    if (gain) {
#pragma unroll
        for (int i = 0; i < 8; ++i) wv[i] = wv[i] * gain[k0 + 8 * i + (lane >> 3)]; }
#pragma unroll
    for (int i = 0; i < 8; ++i) { LAS float* d = scr + (8 * i + (lane >> 3)) * 33 + (lane & 7) * 4; d[0] = wv[i][0]; d[1] = wv[i][1]; d[2] = wv[i][2]; d[3] = wv[i][3]; }
    LDS_WAIT(); asm volatile("" ::: "memory");
    const int c = lane & 7;
#pragma unroll
    for (int j = 0; j < 4; ++j) { const int n = (lane >> 3) + 8 * j; const LAS float* s = scr + (8 * c) * 33 + n;
        u32x4 o; o.x = cvt_pk_bf16(s[0 * 33], s[1 * 33]); o.y = cvt_pk_bf16(s[2 * 33], s[3 * 33]); o.z = cvt_pk_bf16(s[4 * 33], s[5 * 33]); o.w = cvt_pk_bf16(s[6 * 33], s[7 * 33]);
        *(u32x4*)(WT + (size_t)(drow + n) * ldt + k0 + 8 * c) = o; }
    LDS_WAIT(); asm volatile("" ::: "memory");
}
__device__ __forceinline__ float row_to_bf16(const float* xrow, bf16_t* orow, const float* gain, bool normalize, int lane) {
    const f32x4* xr = (const f32x4*)xrow + lane;
    f32x4 v[8]; float s = 0.f;
#pragma unroll
    for (int j = 0; j < 8; ++j) { v[j] = __builtin_nontemporal_load(xr + 64 * j); const f32x4 t = v[j] * v[j]; s += (t[0] + t[1]) + (t[2] + t[3]); }
    const float rstd = rsqrtf(wave_sum(s) * (1.f / 2048.f) + EPSF);
    u32x2* o8 = (u32x2*)orow + lane;
#pragma unroll
    for (int j = 0; j < 8; ++j) { f32x4 w = v[j];
        if (normalize) { const f32x4 g = *((const f32x4*)gain + lane + 64 * j); w = w * rstd * g; }
        u32x2 o; o.x = cvt_pk_bf16(w[0], w[1]); o.y = cvt_pk_bf16(w[2], w[3]); o8[64 * j] = o; }
    return rstd;
}

__device__ __forceinline__ void p0_prologue(const Args& a, LAS unsigned char* lds, int G, int bid, int tid) {
    const int wave = __builtin_amdgcn_readfirstlane(tid >> 6), lane = tid & 63;
    unsigned char* ws = a.ws;
    LAS float* scr = (LAS float*)(lds + wave * 16384);
    const int gw = bid * NWAVES + wave, NGW = G * NWAVES;
    constexpr int J0 = 32 * 160, J1 = 32 * 64, J2 = 32 * 16, J5 = 8 * 64, J6 = 32 * 352, J7 = 88 * 64, J8 = 128;
    constexpr int NITEMS = J0 + J1 + 3 * J2 + J5 + J6 + J8;
    for (int it = gw; it < NITEMS; it += NGW) {
        int r = it;
        if (r < J0) { const int kb = r / 160, ng = r % 160, n0 = 32 * ng, region = n0 >> 10;
            if (region == 2) xpose_item(a.in[I_W_IN], INW, n0, a.in[I_ATTN_NORM], (bf16_t*)(ws + WS_WV), DM, n0 - 2048, 64 * kb, scr, lane);
            else { const int L = n0 - (region > 2 ? 1024 : 0), tile = L >> 8, j = L & 255, wc = j >> 6, bj = (j >> 5) & 1;
                xpose_item(a.in[I_W_IN], INW, n0, a.in[I_ATTN_NORM], (bf16_t*)(ws + WS_WA), DM, tile * 256 + 128 * bj + 32 * wc, 64 * kb, scr, lane); }
            continue; } r -= J0;
        if (r < J1) { xpose_item(a.in[I_W_OUT], DM, 32 * (r % 64), nullptr, (bf16_t*)(ws + WS_WOUT), DM, 32 * (r % 64), 64 * (r / 64), scr, lane); continue; } r -= J1;
        if (r < J2) { xpose_item(a.in[I_XQ_W], XW, 32 * (r % 16), a.in[I_XATTN_NORM], (bf16_t*)(ws + WS_WXQ), DM, 32 * (r % 16), 64 * (r / 16), scr, lane); continue; } r -= J2;
        if (r < J2) { xpose_item(a.in[I_XK_W], XW, 32 * (r % 16), nullptr, (bf16_t*)(ws + WS_WXK), DM, 32 * (r % 16), 64 * (r / 16), scr, lane); continue; } r -= J2;
        if (r < J2) { xpose_item(a.in[I_XV_W], XW, 32 * (r % 16), nullptr, (bf16_t*)(ws + WS_WXV), DM, 32 * (r % 16), 64 * (r / 16), scr, lane); continue; } r -= J2;
        if (r < J5) { xpose_item(a.in[I_XO_W], DM, 32 * (r % 64), nullptr, (bf16_t*)(ws + WS_WXO), XW, 32 * (r % 64), 64 * (r / 64), scr, lane); continue; } r -= J5;
        if (r < J6) { const int kb = r / 352, pg = r % 352, p0 = 32 * pg, T = p0 >> 8, rem = p0 & 255, bj = rem >> 7, r2 = rem & 127;
            xpose_item(a.in[I_W_GU], 2 * DFF, bj * DFF + 128 * T + r2, a.in[I_FFN_NORM], (bf16_t*)(ws + WS_WGU), DM, p0, 64 * kb, scr, lane); continue; } r -= J6;
        { const int gi = r >> 4, which = (r >> 3) & 1, sub = r & 7, kb = sub >> 2, nb = sub & 3;
          xpose_item(a.in[which ? I_GX_W : I_GA_W] + (size_t)gi * 128 * 128, 128, 32 * nb, nullptr, (bf16_t*)(ws + WS_WGATE), 128, gi * 256 + which * 128 + 32 * nb, 64 * kb, scr, lane); }
    }
    float* rstd1 = (float*)(ws + WS_RSTD1);
    for (int grp = bid; grp < SEQ / 32; grp += G)
        for (int k = 0; k < 4; ++k) { const int m = grp * 32 + k * 8 + wave; const float rs = row_to_bf16(a.in[I_X] + (size_t)m * DM, (bf16_t*)(ws + WS_XB) + (size_t)m * DM, nullptr, false, lane); if (lane == 0) rstd1[m] = rs; }
    for (int m = gw; m < MEML; m += NGW) row_to_bf16(a.in[I_MEM] + (size_t)m * DM, (bf16_t*)(ws + WS_MEMN) + (size_t)m * DM, a.in[I_MEM_NORM], true, lane);
    for (int c = bid * NTHREADS + tid; c < RW; c += G * NTHREADS) ((float*)(ws + WS_SPL))[c] = 8.f * LOG2E * log1pf(expf(-a.in[I_RGL][c]));
}

__device__ __forceinline__ void wdn_convert(const Args& a, LAS unsigned char* lds, int nb, int rk, int tid) {
    const int wave = __builtin_amdgcn_readfirstlane(tid >> 6), lane = tid & 63;
    LAS float* scr = (LAS float*)(lds + wave * 16384);
    for (int r = rk * NWAVES + wave; r < 88 * 64; r += nb * NWAVES)
        xpose_item(a.in[I_W_DN], DM, 32 * (r % 64), nullptr, (bf16_t*)(a.ws + WS_WDN), DFF, 32 * (r % 64), 64 * (r / 64), scr, lane);
}
__device__ __forceinline__ void mk_norm_phase(const Args& a, int G, int bid, int tid) {
    const int wave = tid >> 6, lane = tid & 63;
    const float* raw = (const float*)(a.ws + WS_MKRAW); bf16_t* mkn = (bf16_t*)(a.ws + WS_MKN);
    for (int p = bid * NWAVES + wave; p < MEML * 4; p += G * NWAVES) {
        const float2 v = *(const float2*)(raw + (size_t)p * 128 + 2 * lane);
        const float r = rsqrtf(wave_sum(v.x * v.x + v.y * v.y) * (1.f / 128.f) + EPSF);
        const float2 g = *(const float2*)(a.in[I_XK_NORM] + 2 * lane);
        *(unsigned*)(mkn + (size_t)p * 128 + 2 * lane) = cvt_pk_bf16(v.x * r * g.x, v.y * r * g.y);
    }
}
__device__ __forceinline__ void mk_norm_cols(const Args& a, int pn, int tid) {
    const int wave = tid >> 6, lane = tid & 63;
    const float* raw = (const float*)(a.ws + WS_MKRAW); bf16_t* mkn = (bf16_t*)(a.ws + WS_MKN);
    for (int q = wave; q < MEML * 2; q += NWAVES) { const int row = q >> 1, head = pn * 2 + (q & 1); const size_t p = (size_t)row * 4 + head;
        const float2 v = *(const float2*)(raw + p * 128 + 2 * lane);
        const float r = rsqrtf(wave_sum(v.x * v.x + v.y * v.y) * (1.f / 128.f) + EPSF);
        const float2 g = *(const float2*)(a.in[I_XK_NORM] + 2 * lane);
        *(unsigned*)(mkn + p * 128 + 2 * lane) = cvt_pk_bf16(v.x * r * g.x, v.y * r * g.y); }
}
__device__ __forceinline__ void conv_phase(const Args& a, int G, int bid, int tid) {
    const bf16_t* xr = (const bf16_t*)(a.ws + WS_XR); bf16_t* xc = (bf16_t*)(a.ws + WS_XC);
    const int cg8 = (tid & 127) * 8, rsub = tid >> 7;
    float w[4][8], b[8];
#pragma unroll
    for (int j = 0; j < 4; ++j)
#pragma unroll
        for (int e = 0; e < 8; ++e) w[j][e] = a.in[I_CONV_W][j * RW + cg8 + e];
#pragma unroll
    for (int e = 0; e < 8; ++e) b[e] = a.in[I_CONV_B][cg8 + e];
    for (int it = bid; it < SEQ / 32; it += G) {
        const int t0 = it * 32 + rsub * 8;
        float win[3][8];
#pragma unroll
        for (int j = 0; j < 3; ++j) { const int t = t0 - 3 + j; u32x4 x = (u32x4){0u, 0u, 0u, 0u}; if (t >= 0) x = *(const u32x4*)(xr + (size_t)t * RW + cg8);
            win[j][0] = bf_lo(x.x); win[j][1] = bf_hi(x.x); win[j][2] = bf_lo(x.y); win[j][3] = bf_hi(x.y); win[j][4] = bf_lo(x.z); win[j][5] = bf_hi(x.z); win[j][6] = bf_lo(x.w); win[j][7] = bf_hi(x.w); }
#pragma unroll
        for (int i = 0; i < 8; ++i) { const int t = t0 + i; const u32x4 x = *(const u32x4*)(xr + (size_t)t * RW + cg8);
            float cur[8] = {bf_lo(x.x), bf_hi(x.x), bf_lo(x.y), bf_hi(x.y), bf_lo(x.z), bf_hi(x.z), bf_lo(x.w), bf_hi(x.w)};
            float o[8];
#pragma unroll
            for (int e = 0; e < 8; ++e) { o[e] = b[e] + w[0][e] * win[0][e] + w[1][e] * win[1][e] + w[2][e] * win[2][e] + w[3][e] * cur[e]; win[0][e] = win[1][e]; win[1][e] = win[2][e]; win[2][e] = cur[e]; }
            u32x4 ow; ow.x = cvt_pk_bf16(o[0], o[1]); ow.y = cvt_pk_bf16(o[2], o[3]); ow.z = cvt_pk_bf16(o[4], o[5]); ow.w = cvt_pk_bf16(o[6], o[7]);
            *(u32x4*)(xc + (size_t)t * RW + cg8) = ow; }
    }
}
#define MFMA32(a, b, c) __builtin_amdgcn_mfma_f32_32x32x16_bf16((a), (b), (c), 0, 0, 0)
__device__ __forceinline__ void rnn_front_phase(const Args& a, LAS unsigned char* lds, int G, int bid, int tid) {
    const int wid = __builtin_amdgcn_readfirstlane(tid >> 6), lane = tid & 63, r = lane & 31, h = lane >> 5;
    const bf16_t* XR = (const bf16_t*)(a.ws + WS_XR); const bf16_t* WG = (const bf16_t*)(a.ws + WS_WGATE);
    bf16_t* LAo = (bf16_t*)(a.ws + WS_LA); bf16_t* Uo = (bf16_t*)(a.ws + WS_U);
    float* As = (float*)(a.ws + WS_AS); float* He = (float*)(a.ws + WS_HEND);
    LAS float* LAb = (LAS float*)(lds + 49152); LAS float* Ub = (LAS float*)(lds + 81920);
    LAS float* GX = (LAS float*)(lds + 16384) + (wid & 3) * 2048;
    int gcur = -1; bf16x8 Bf[8];
    float ba = 0.f, bx = 0.f, sp = 0.f;
    u32x4 xq[5];
#define RNN_LOADX(itx) do { const int g_ = (itx) & 7, j_ = (itx) >> 3, co_ = tid & 15, rp_ = tid >> 4; \
        _Pragma("unroll") for (int q = 0; q < 5; ++q) { const int t = 64 * j_ + 2 * rp_ - 3 + q; xq[q] = (u32x4){0u, 0u, 0u, 0u}; if (t >= 0) xq[q] = *(const u32x4*)(XR + (size_t)t * RW + 128 * g_ + co_ * 8); } } while (0)
    if (bid < (SEQ / 64) * 8) RNN_LOADX(bid);
    for (int it = bid; it < (SEQ / 64) * 8; it += G) {
        const int g = it & 7, j = it >> 3, t0 = 64 * j, c0 = 128 * g;
        if (g != gcur) { gcur = g;
#pragma unroll
            for (int s = 0; s < 8; ++s) Bf[s] = *(const bf16x8*)(WG + (size_t)(g * 256 + 32 * wid + r) * 128 + 16 * s + 8 * h);
            const int cgh = c0 + (wid & 3) * 32 + r;
            ba = a.in[I_GA_B][cgh]; bx = a.in[I_GX_B][cgh]; sp = ((const float*)(a.ws + WS_SPL))[cgh]; }
        { const int co = tid & 15, rp = tid >> 4, ch = c0 + co * 8;
          float acc0[8], acc1[8];
#pragma unroll
          for (int e = 0; e < 8; ++e) { acc0[e] = a.in[I_CONV_B][ch + e]; acc1[e] = acc0[e]; }
#pragma unroll
          for (int jj = 0; jj < 4; ++jj) { const f32x4 w0 = *(const f32x4*)(a.in[I_CONV_W] + jj * RW + ch), w1 = *(const f32x4*)(a.in[I_CONV_W] + jj * RW + ch + 4);
              const u32x4 xa = xq[jj], xb = xq[jj + 1];
              const float va[8] = {bf_lo(xa.x), bf_hi(xa.x), bf_lo(xa.y), bf_hi(xa.y), bf_lo(xa.z), bf_hi(xa.z), bf_lo(xa.w), bf_hi(xa.w)};
              const float vb[8] = {bf_lo(xb.x), bf_hi(xb.x), bf_lo(xb.y), bf_hi(xb.y), bf_lo(xb.z), bf_hi(xb.z), bf_lo(xb.w), bf_hi(xb.w)};
#pragma unroll
              for (int e = 0; e < 8; ++e) { const float wv = e < 4 ? w0[e & 3] : w1[e & 3]; acc0[e] += wv * va[e]; acc1[e] += wv * vb[e]; } }
          const int r0 = 2 * rp, r1 = 2 * rp + 1;
          u32x4 o0, o1; o0.x = cvt_pk_bf16(acc0[0], acc0[1]); o0.y = cvt_pk_bf16(acc0[2], acc0[3]); o0.z = cvt_pk_bf16(acc0[4], acc0[5]); o0.w = cvt_pk_bf16(acc0[6], acc0[7]);
          o1.x = cvt_pk_bf16(acc1[0], acc1[1]); o1.y = cvt_pk_bf16(acc1[2], acc1[3]); o1.z = cvt_pk_bf16(acc1[4], acc1[5]); o1.w = cvt_pk_bf16(acc1[6], acc1[7]);
          *(LAS u32x4*)(lds + r0 * 256 + ((co ^ (r0 & 15)) << 4)) = o0;
          *(LAS u32x4*)(lds + r1 * 256 + ((co ^ (r1 & 15)) << 4)) = o1; }
        __syncthreads();
        f32x16 D[2];
#pragma unroll
        for (int mt = 0; mt < 2; ++mt) {
#pragma unroll
            for (int i = 0; i < 16; ++i) D[mt][i] = 0.f;
            const int row = 32 * mt + r;
#pragma unroll
            for (int s = 0; s < 8; ++s) { const bf16x8 xa = *(const LAS bf16x8*)(lds + row * 256 + (((2 * s + h) ^ (row & 15)) << 4)); D[mt] = MFMA32(xa, Bf[s], D[mt]); } }
        const int cl = (wid & 3) * 32 + r, cgl = c0 + cl;
        if (wid < 4) {
#pragma unroll
            for (int i = 0; i < 16; ++i) GX[1024 + i * 64 + lane] = D[1][i]; }
        else {
#pragma unroll
            for (int i = 0; i < 16; ++i) GX[i * 64 + lane] = D[0][i]; }
        __syncthreads();
        {
#define RNN_FIN(PA, PX, MT) do { _Pragma("unroll") for (int i = 0; i < 16; ++i) { const int row = 32 * (MT) + (i & 3) + 8 * (i >> 2) + 4 * h; \
                const float ga = __builtin_amdgcn_rcpf(1.f + __builtin_amdgcn_exp2f(-((PA) + ba) * LOG2E)); \
                const float gx = __builtin_amdgcn_rcpf(1.f + __builtin_amdgcn_exp2f(-((PX) + bx) * LOG2E)); \
                const float l2 = -ga * sp; \
                const float xl = 2.f * l2 * 0.6931471805599453f; \
                const float om = xl > -0.02f ? -(xl + xl * xl * (0.5f + xl * (1.f / 6.f))) : 1.f - __builtin_amdgcn_exp2f(2.f * l2); \
                const float xcv = bf_lo((unsigned)*(const LAS unsigned short*)(lds + row * 256 + (((cl >> 3) ^ (row & 15)) << 4) + (cl & 7) * 2)); \
                const float uv = xcv * gx * __builtin_amdgcn_sqrtf(om); \
                LAb[row * 128 + cl] = bf_lo(cvt_pk_bf16(l2, 0.f)); Ub[row * 128 + cl] = bf_lo(cvt_pk_bf16(uv, 0.f)); } } while (0)
          if (wid < 4) RNN_FIN(D[0][i], GX[i * 64 + lane], 0);
          else RNN_FIN(GX[1024 + i * 64 + lane], D[1][i], 1);
#undef RNN_FIN
        }
        __syncthreads();
        if (it + G < (SEQ / 64) * 8) RNN_LOADX(it + G);
#pragma unroll
        for (int q = 0; q < 2; ++q) { const int idx = tid + NTHREADS * q, row = idx >> 4, oc = idx & 15;
            const f32x4 l0 = *(const LAS f32x4*)(LAb + row * 128 + oc * 8), l1 = *(const LAS f32x4*)(LAb + row * 128 + oc * 8 + 4);
            const f32x4 u0 = *(const LAS f32x4*)(Ub + row * 128 + oc * 8), u1 = *(const LAS f32x4*)(Ub + row * 128 + oc * 8 + 4);
            *(u32x4*)(LAo + (size_t)(t0 + row) * RW + c0 + oc * 8) = pack8(l0, l1);
            *(u32x4*)(Uo + (size_t)(t0 + row) * RW + c0 + oc * 8) = pack8(u0, u1); }
        if (tid < 128) { float hh = 0.f, ssum = 0.f;
#pragma unroll 16
            for (int t = 0; t < 64; ++t) { const float l = LAb[t * 128 + tid], uu = Ub[t * 128 + tid]; ssum += l; hh = __builtin_amdgcn_exp2f(l) * hh + uu; }
            As[(size_t)j * RW + c0 + tid] = __builtin_amdgcn_exp2f(ssum); He[(size_t)j * RW + c0 + tid] = hh; }
    }
#undef RNN_LOADX
}
__device__ __forceinline__ void scanA_phase(const Args& a, int G, int bid, int tid) {
    const bf16_t* la = (const bf16_t*)(a.ws + WS_LA); const bf16_t* uu = (const bf16_t*)(a.ws + WS_U);
    float* As = (float*)(a.ws + WS_AS); float* He = (float*)(a.ws + WS_HEND);
    for (int ch = bid; ch < SEQ / 64; ch += G) {
        float h0 = 0.f, h1 = 0.f, s0 = 0.f, s1 = 0.f;
        const size_t base = (size_t)ch * 64 * RW + 2 * tid;
#pragma unroll 16
        for (int t = 0; t < 64; ++t) { const unsigned l = *(const unsigned*)(la + base + (size_t)t * RW), u = *(const unsigned*)(uu + base + (size_t)t * RW);
            const float l0 = bf_lo(l), l1 = bf_hi(l); s0 += l0; s1 += l1;
            h0 = __builtin_amdgcn_exp2f(l0) * h0 + bf_lo(u); h1 = __builtin_amdgcn_exp2f(l1) * h1 + bf_hi(u); }
        *(float2*)(As + (size_t)ch * RW + 2 * tid) = make_float2(s0, s1);
        *(float2*)(He + (size_t)ch * RW + 2 * tid) = make_float2(h0, h1);
    }
}
__device__ __forceinline__ float gelu_tanh(float y) {
    const float z = 0.7978845608028654f * (y + 0.044715f * y * y * y);
    const float e = __builtin_amdgcn_exp2f(2.f * LOG2E * z);
    const float th = 1.f - 2.f * __builtin_amdgcn_rcpf(1.f + e);
    return 0.5f * y * (1.f + th);
}
__device__ __forceinline__ void scanC_phase(const Args& a, LAS unsigned char* lds, int G, int bid, int tid) {
    const bf16_t* la = (const bf16_t*)(a.ws + WS_LA); const bf16_t* uu = (const bf16_t*)(a.ws + WS_U); const bf16_t* yr = (const bf16_t*)(a.ws + WS_YR);
    const float* As = (const float*)(a.ws + WS_AS); const float* He = (const float*)(a.ws + WS_HEND);
    bf16_t* mix = (bf16_t*)(a.ws + WS_MIX);
    const int wave = tid >> 6, lane = tid & 63;
    for (int ch = bid; ch < SEQ / 64; ch += G) {
        float h0 = 0.f, h1 = 0.f;
#pragma unroll 32
        for (int j = 0; j < ch; ++j) { const float2 s = *(const float2*)(As + (size_t)j * RW + 2 * tid), e = *(const float2*)(He + (size_t)j * RW + 2 * tid);
            h0 = s.x * h0 + e.x; h1 = s.y * h1 + e.y; }
        const size_t base = (size_t)ch * 64 * RW + 2 * tid;
#pragma unroll 16
        for (int t = 0; t < 64; ++t) { const unsigned l = *(const unsigned*)(la + base + (size_t)t * RW), u = *(const unsigned*)(uu + base + (size_t)t * RW), y = *(const unsigned*)(yr + base + (size_t)t * RW);
            h0 = __builtin_amdgcn_exp2f(bf_lo(l)) * h0 + bf_lo(u); h1 = __builtin_amdgcn_exp2f(bf_hi(l)) * h1 + bf_hi(u);
            *(LAS unsigned*)(lds + t * 2048 + tid * 4) = cvt_pk_bf16(h0 * gelu_tanh(bf_lo(y)), h1 * gelu_tanh(bf_hi(y))); }
        __syncthreads();
#pragma unroll
        for (int rr = 0; rr < 8; ++rr) { const int t = wave * 8 + rr;
            const u32x4 x0 = *(const LAS u32x4*)(lds + t * 2048 + lane * 16), x1 = *(const LAS u32x4*)(lds + t * 2048 + 1024 + lane * 16);
            float v[16] = {bf_lo(x0.x), bf_hi(x0.x), bf_lo(x0.y), bf_hi(x0.y), bf_lo(x0.z), bf_hi(x0.z), bf_lo(x0.w), bf_hi(x0.w),
                           bf_lo(x1.x), bf_hi(x1.x), bf_lo(x1.y), bf_hi(x1.y), bf_lo(x1.z), bf_hi(x1.z), bf_lo(x1.w), bf_hi(x1.w)};
            float ss = 0.f;
#pragma unroll
            for (int e = 0; e < 16; ++e) ss += v[e] * v[e];
            const float r = rsqrtf(wave_sum(ss) * (1.f / 1024.f) + EPSF);
            const float* gn = a.in[I_RNN_NORM];
#pragma unroll
            for (int hh = 0; hh < 2; ++hh) { const int c = hh * 512 + lane * 8; const f32x4 g0 = *(const f32x4*)(gn + c), g1 = *(const f32x4*)(gn + c + 4);
                u32x4 o; o.x = cvt_pk_bf16(v[8 * hh + 0] * r * g0[0], v[8 * hh + 1] * r * g0[1]); o.y = cvt_pk_bf16(v[8 * hh + 2] * r * g0[2], v[8 * hh + 3] * r * g0[3]);
                o.z = cvt_pk_bf16(v[8 * hh + 4] * r * g1[0], v[8 * hh + 5] * r * g1[1]); o.w = cvt_pk_bf16(v[8 * hh + 6] * r * g1[2], v[8 * hh + 7] * r * g1[3]);
                *(u32x4*)(mix + (size_t)(ch * 64 + t) * DM + AW + c) = o; } }
        __syncthreads();
    }
}
__device__ __forceinline__ int t5_bucket(int rel) {
    const int n = rel < 0 ? -rel : rel;
    int large = 8 + (int)(logf((float)(n < 1 ? 1 : n) / 8.0f) / 4.852030263919617f * 8.0f);
    large = large < 15 ? large : 15;
    return (rel > 0 ? 16 : 0) + (n < 8 ? n : large);
}
__device__ __forceinline__ void attn_phase(const Args& a, LAS unsigned char* lds, int G, int bid, int tid) {
    const int wid = __builtin_amdgcn_readfirstlane(tid >> 6), lane = tid & 63, r = lane & 31, h = lane >> 5;
    const bf16_t* Q = (const bf16_t*)(a.ws + WS_Q); const bf16_t* Kb = (const bf16_t*)(a.ws + WS_K); const bf16_t* VT = (const bf16_t*)(a.ws + WS_VT);
    bf16_t* mix = (bf16_t*)(a.ws + WS_MIX);
    LAS float* tab = (LAS float*)(lds + 132096);
    float lam;
    { const float s1 = wave_sum(a.in[I_LQ1][lane] * a.in[I_LK1][lane]), s2 = wave_sum(a.in[I_LQ2][lane] * a.in[I_LK2][lane]); lam = __uint_as_float(__builtin_amdgcn_readfirstlane(__float_as_uint(expf(s1) - expf(s2) + 0.2f))); }
    const int rowk = (r & 0x13) | ((r & 4) << 1) | ((r & 8) >> 1);
    const int koff0 = rowk * 128 + ((h ^ ((rowk >> 1) & 7)) << 4), voff0 = r * 128 + ((h ^ ((r >> 1) & 7)) << 4);
#define KOFF(s) (koff0 ^ ((s) << 5))
#define VOFF(s) (16384 + (voff0 ^ ((s) << 5)))
    const unsigned ldsw = (unsigned)wid * 1024u;

    int tabhead = -1;
    for (int ui = 0;; ++ui) {
        const int uidx = ui * G + bid; if (uidx >= 512) break;
        const int cc = uidx & 255, rnd = uidx >> 8, head = cc & 7, jj = cc >> 3;
        const int qb = rnd == 0 ? 63 - jj : jj;
        const int q0 = qb * 256, nst = 2 * qb + 2, cw = 4 * qb + (wid >> 1), qw = q0 + 32 * wid;
        int tu_ = threadIdx.x; asm volatile("" : "+v"(tu_));
        if (head != tabhead) { tabhead = head;
            for (int idx = tu_; idx < 1408; idx += NTHREADS) tab[idx] = a.in[I_RELB][t5_bucket(63 - idx) * 8 + head] * LOG2E; }
        const float farb = a.in[I_RELB][15 * 8 + head] * LOG2E;
        bf16x8 Qf[2][4];
#pragma unroll
        for (int mp = 0; mp < 2; ++mp)
#pragma unroll
            for (int s = 0; s < 4; ++s) Qf[mp][s] = *(const bf16x8*)(Q + (size_t)(qw + (tu_ & 31)) * AW + head * 128 + mp * 64 + 16 * s + 8 * ((tu_ >> 5) & 1));
        const bf16_t* kbase = Kb + head * 128; const bf16_t* vbase = VT + (size_t)head * 128 * SEQ;
#define ATT_GLDS(src, off) __builtin_amdgcn_global_load_lds((const unsigned*)(src), (LAS unsigned*)(lds + (off) + ldsw), 16, 0, 0)
#define ATT_DMA(p, b) do { int td_ = threadIdx.x; asm volatile("" : "+v"(td_));     \
            const int prow = td_ >> 3, pch = (td_ & 7) ^ ((prow >> 1) & 7); const unsigned gK = (unsigned)(prow * AW + pch * 8), gV = (unsigned)(prow * SEQ + pch * 8); \
            _Pragma("unroll") for (int sub = 0; sub < 2; ++sub) { const int k0_ = 128 * (p) + 64 * sub; const unsigned o_ = (unsigned)(b) * 65536u + (unsigned)sub * 32768u; \
            ATT_GLDS(kbase + (size_t)k0_ * AW + gK, o_); ATT_GLDS(kbase + (size_t)k0_ * AW + gK + 64, o_ + 8192u); \
            ATT_GLDS(vbase + gV + k0_, o_ + 16384u); ATT_GLDS(vbase + (size_t)64 * SEQ + gV + k0_, o_ + 24576u); } } while (0)
        ATT_DMA(0, 0);
        asm volatile("s_waitcnt vmcnt(0)" ::: "memory"); __syncthreads();
        f32x16 O1[4], O2[4];
#pragma unroll
        for (int dt = 0; dt < 4; ++dt)
#pragma unroll
            for (int i = 0; i < 16; ++i) { O1[dt][i] = 0.f; O2[dt][i] = 0.f; }
        f32x2_t sum1 = {0.f, 0.f}, sum2 = {0.f, 0.f};
        int pfar = (q0 - 1086 + 63) >> 7; pfar = pfar < 0 ? 0 : pfar;
        const float farscale = __builtin_amdgcn_exp2f(farb);
#define ATT_SB() __builtin_amdgcn_sched_barrier(0)
#define ATT_LDK(mo, s, kt) (*(const LAS bf16x8*)(buf + (mo) + KOFF(s) + (kt) * 4096))
#define ATT_LDV(c, dt) (*(const LAS bf16x8*)(buf + VOFF(c) + (dt) * 4096))
#define ATT_EXP(S, sum, pb) do { _Pragma("unroll") for (int s = 0; s < 2; ++s) { unsigned w[4]; \
            _Pragma("unroll") for (int pp = 0; pp < 4; ++pp) { const int i0 = 8 * s + 2 * pp; \
                const f32x2_t e = {__builtin_amdgcn_exp2f(S[i0]), __builtin_amdgcn_exp2f(S[i0 + 1])}; sum += e; w[pp] = cvt_pk_bf16(e[0], e[1]); } \
            pb[s] = __builtin_bit_cast(bf16x8, ((u32x4){w[0], w[1], w[2], w[3]})); } } while (0)
#define ATT_PV(va, s, d0) do { O1[d0] = MFMA32(va[0], pb1[s], O1[d0]); O2[d0] = MFMA32(va[0], pb2[s], O2[d0]); O1[d0 + 1] = MFMA32(va[1], pb1[s], O1[d0 + 1]); O2[d0 + 1] = MFMA32(va[1], pb2[s], O2[d0 + 1]); } while (0)
#define ATT_SUBTILE(INIT) do { bf16x8 kA[4], vA[2], pb1[2], pb2[2]; \
            _Pragma("unroll") for (int s = 0; s < 4; ++s) kA[s] = ATT_LDK(0, s, 0); \
            ATT_SB(); \
            _Pragma("unroll") for (int kt = 0; kt < 2; ++kt) { \
                f32x16 S; INIT(S); _Pragma("unroll") for (int s = 0; s < 4; ++s) S = MFMA32(kA[s], Qf[0][s], S); \
                ATT_SB(); \
                _Pragma("unroll") for (int s = 0; s < 4; ++s) kA[s] = ATT_LDK(8192, s, kt); \
                ATT_EXP(S, sum1, pb1); \
                ATT_SB(); \
                INIT(S); _Pragma("unroll") for (int s = 0; s < 4; ++s) S = MFMA32(kA[s], Qf[1][s], S); \
                ATT_SB(); \
                vA[0] = ATT_LDV(2 * kt, 0); vA[1] = ATT_LDV(2 * kt, 1); kA[0] = ATT_LDV(2 * kt, 2); kA[1] = ATT_LDV(2 * kt, 3); \
                ATT_EXP(S, sum2, pb2); \
                ATT_SB(); \
                ATT_PV(vA, 0, 0); \
                ATT_SB(); \
                vA[0] = ATT_LDV(2 * kt + 1, 0); vA[1] = ATT_LDV(2 * kt + 1, 1); ATT_PV(kA, 0, 2); \
                ATT_SB(); \
                kA[0] = ATT_LDV(2 * kt + 1, 2); kA[1] = ATT_LDV(2 * kt + 1, 3); ATT_PV(vA, 1, 0); \
                ATT_SB(); \
                ATT_PV(kA, 1, 2); \
                ATT_SB(); \
                if (kt == 0) { _Pragma("unroll") for (int s = 0; s < 4; ++s) kA[s] = ATT_LDK(0, s, 1); ATT_SB(); } } } while (0)
#define ATT_INIT_ZERO(S) do { _Pragma("unroll") for (int i = 0; i < 16; ++i) S[i] = 0.f; } while (0)
#define ATT_INIT_TAB(S) do { const int ib = ib0 - 32 * kt; _Pragma("unroll") for (int i = 0; i < 16; ++i) S[i] = tab[ib - (16 * (i >> 3) + (i & 7))]; } while (0)
        int p = 0;
        for (; p < pfar; ++p) {
            LAS unsigned char* const sbase = lds + (p & 1) * 65536;
#pragma unroll 1
            for (int sub = 0; sub < 2; ++sub) {
                if ((wid >= 4) == (sub == 0)) ATT_DMA(p + 1, (p + 1) & 1);
                LAS unsigned char* buf = sbase + sub * 32768;
                ATT_SUBTILE(ATT_INIT_ZERO);
            }
            asm volatile("s_waitcnt vmcnt(0)" ::: "memory"); __syncthreads();
        }
#pragma unroll
        for (int dt = 0; dt < 4; ++dt) { O1[dt] = O1[dt] * farscale; O2[dt] = O2[dt] * farscale; }
        sum1 = sum1 * farscale; sum2 = sum2 * farscale;
        for (; p < nst; ++p) {
            LAS unsigned char* const sbase = lds + (p & 1) * 65536;
#pragma unroll 1
            for (int sub = 0; sub < 2; ++sub) {
                if (p + 1 < nst && (wid >= 4) == (sub == 0)) ATT_DMA(p + 1, (p + 1) & 1);
                const int stl = 2 * p + sub;
                if (stl <= cw) {
                    LAS unsigned char* buf = sbase + sub * 32768;
                    const int k0 = 64 * stl;
                    const int ib0 = (qw + r) - k0 - 8 * h + 63;
                    ATT_SUBTILE(ATT_INIT_TAB);
                }
            }
            asm volatile("s_waitcnt vmcnt(0)" ::: "memory"); __syncthreads();
        }
#undef ATT_SUBTILE
        float t1 = sum1[0] + sum1[1], t2 = sum2[0] + sum2[1];
        t1 += __shfl_xor(t1, 32); t2 += __shfl_xor(t2, 32);
        const float i1 = 1.f / t1, i2 = lam / t2; float ss = 0.f;
#pragma unroll
        for (int dt = 0; dt < 4; ++dt)
#pragma unroll
            for (int i = 0; i < 16; ++i) { const float o = O1[dt][i] * i1 - O2[dt][i] * i2; O1[dt][i] = o; ss += o * o; }
        ss += __shfl_xor(ss, 32);
        const float rs = rsqrtf(ss * (1.f / 128.f) + EPSF) * 0.8f;
        int te_ = threadIdx.x; asm volatile("" : "+v"(te_)); const int re_ = te_ & 31, he_ = (te_ >> 5) & 1;
        bf16_t* orow = mix + (size_t)(qw + re_) * DM + head * 128;
#pragma unroll
        for (int dt = 0; dt < 4; ++dt)
#pragma unroll
            for (int g4 = 0; g4 < 4; ++g4) { const int d = 32 * dt + 8 * g4 + 4 * he_; const f32x4 gn = *(const f32x4*)(a.in[I_SUBLN] + d);
                u32x2 o; o.x = cvt_pk_bf16(O1[dt][4 * g4] * rs * gn[0], O1[dt][4 * g4 + 1] * rs * gn[1]); o.y = cvt_pk_bf16(O1[dt][4 * g4 + 2] * rs * gn[2], O1[dt][4 * g4 + 3] * rs * gn[3]);
                *(u32x2*)(orow + d) = o; }
    }
#undef ATT_DMA
#undef ATT_GLDS
}

__device__ __forceinline__ void xattn_phase(const Args& a, LAS unsigned char* lds, int G, int bid, int tid) {
    const int wid = __builtin_amdgcn_readfirstlane(tid >> 6), lane = tid & 63, r = lane & 31, h = lane >> 5;
    const bf16_t* XQ = (const bf16_t*)(a.ws + WS_XQ); const float* MKR = (const float*)(a.ws + WS_MKRAW); const bf16_t* MVT = (const bf16_t*)(a.ws + WS_MVT);
    bf16_t* XO = (bf16_t*)(a.ws + WS_XOIN);
    const int rowk = (r & 0x13) | ((r & 4) << 1) | ((r & 8) >> 1);
    const float qsc = 0.08838834764831845f * LOG2E;
    for (int ub = bid; ub < 256; ub += G) {
        const int head = ub & 3, t = ((ub >> 2) * 8 + wid) * 32 + r;
#pragma unroll
        for (int i = 0; i < 8; ++i) { const int piece = wid * 8 + i;
            { const int row = piece * 2 + (lane >> 5), ch = (lane & 31) ^ (row & 15);
              __builtin_amdgcn_global_load_lds((const unsigned*)(MVT + (size_t)(head * 128 + row) * MEML + ch * 8), (LAS unsigned*)(lds + 65536 + piece * 1024), 16, 0, 0); } }
        { const float2 gk = *(const float2*)(a.in[I_XK_NORM] + 2 * lane);
#pragma unroll 1
          for (int i = 0; i < 4; ++i) { float2 kv[8];
#pragma unroll
            for (int j = 0; j < 8; ++j) kv[j] = *(const float2*)(MKR + (size_t)(wid * 32 + i * 8 + j) * XW + head * 128 + 2 * lane);
#pragma unroll
            for (int j = 0; j < 8; ++j) { const int row = wid * 32 + i * 8 + j;
                const float rk = rsqrtf(wave_sum(kv[j].x * kv[j].x + kv[j].y * kv[j].y) * (1.f / 128.f) + EPSF);
                *(LAS unsigned*)(lds + row * 256 + (((lane >> 2) ^ (row & 15)) << 4) + (lane & 3) * 4) = cvt_pk_bf16(kv[j].x * rk * gk.x, kv[j].y * rk * gk.y); } } }
        u32x4 qv[8]; float ss = 0.f;
#pragma unroll
        for (int s = 0; s < 8; ++s) { qv[s] = *(const u32x4*)(XQ + (size_t)t * XW + head * 128 + 16 * s + 8 * h);
            const float e0 = bf_lo(qv[s].x), e1 = bf_hi(qv[s].x), e2 = bf_lo(qv[s].y), e3 = bf_hi(qv[s].y), e4 = bf_lo(qv[s].z), e5 = bf_hi(qv[s].z), e6 = bf_lo(qv[s].w), e7 = bf_hi(qv[s].w);
            ss += (e0 * e0 + e1 * e1) + (e2 * e2 + e3 * e3) + (e4 * e4 + e5 * e5) + (e6 * e6 + e7 * e7); }
        ss += __shfl_xor(ss, 32);
        const float rq = rsqrtf(ss * (1.f / 128.f) + EPSF) * qsc;
#pragma unroll
        for (int s = 0; s < 8; ++s) { const f32x4 g0 = *(const f32x4*)(a.in[I_XQ_NORM] + 16 * s + 8 * h), g1 = *(const f32x4*)(a.in[I_XQ_NORM] + 16 * s + 8 * h + 4);
            u32x4 w; w.x = cvt_pk_bf16(bf_lo(qv[s].x) * rq * g0[0], bf_hi(qv[s].x) * rq * g0[1]); w.y = cvt_pk_bf16(bf_lo(qv[s].y) * rq * g0[2], bf_hi(qv[s].y) * rq * g0[3]);
            w.z = cvt_pk_bf16(bf_lo(qv[s].z) * rq * g1[0], bf_hi(qv[s].z) * rq * g1[1]); w.w = cvt_pk_bf16(bf_lo(qv[s].w) * rq * g1[2], bf_hi(qv[s].w) * rq * g1[3]); qv[s] = w; }
        asm volatile("s_waitcnt vmcnt(0)" ::: "memory"); __syncthreads();
        f32x16 O[4];
#pragma unroll
        for (int dt = 0; dt < 4; ++dt)
#pragma unroll
            for (int i = 0; i < 16; ++i) O[dt][i] = 0.f;
        f32x2_t sum = {0.f, 0.f};
#pragma unroll 2
        for (int kt = 0; kt < 8; ++kt) {
            f32x16 sacc;
#pragma unroll
            for (int i = 0; i < 16; ++i) sacc[i] = 0.f;
            const int krow = 32 * kt + rowk;
#pragma unroll
            for (int s = 0; s < 8; ++s) { const bf16x8 ka = *(const LAS bf16x8*)(lds + krow * 256 + (((2 * s + h) ^ (krow & 15)) << 4)); sacc = MFMA32(ka, __builtin_bit_cast(bf16x8, qv[s]), sacc); }
            u32x4 pb[2];
#pragma unroll
            for (int s = 0; s < 2; ++s) { unsigned w[4];
#pragma unroll
                for (int p = 0; p < 4; ++p) { const f32x2_t e = {__builtin_amdgcn_exp2f(sacc[8 * s + 2 * p]), __builtin_amdgcn_exp2f(sacc[8 * s + 2 * p + 1])}; sum += e; w[p] = cvt_pk_bf16(e[0], e[1]); }
                pb[s] = (u32x4){w[0], w[1], w[2], w[3]}; }
#pragma unroll
            for (int dt = 0; dt < 4; ++dt)
#pragma unroll
                for (int s = 0; s < 2; ++s) { const int vrow = 32 * dt + r, c = 4 * kt + 2 * s + h;
                    const bf16x8 va = *(const LAS bf16x8*)(lds + 65536 + vrow * 512 + ((c ^ (vrow & 15)) << 4));
                    O[dt] = MFMA32(va, __builtin_bit_cast(bf16x8, pb[s]), O[dt]); }
        }
        float tot = sum[0] + sum[1]; tot += __shfl_xor(tot, 32);
        const float inv = 1.f / tot;
        bf16_t* orow = XO + (size_t)t * XW + head * 128;
#pragma unroll
        for (int dt = 0; dt < 4; ++dt)
#pragma unroll
            for (int g4 = 0; g4 < 4; ++g4) { u32x2 o; o.x = cvt_pk_bf16(O[dt][4 * g4] * inv, O[dt][4 * g4 + 1] * inv); o.y = cvt_pk_bf16(O[dt][4 * g4 + 2] * inv, O[dt][4 * g4 + 3] * inv);
                *(u32x2*)(orow + 32 * dt + 8 * g4 + 4 * h) = o; }
        __syncthreads();
    }
}

#define XB_TMO      128
#define XB_XCNT(j)  (256  + 64 * (j))
#define XB_XSUB(j)  (1280 + 64 * (j))
#define XB_XGEN(j)  (2304 + 64 * (j))
#define XB_TOP      3328
#define XB_TOPGEN   3392
#define XCD_BAR_WORDS 3456
#define XB_SPIN_CAP (1u << 18)

__device__ __forceinline__ unsigned xb_ld(unsigned* p)              { return __hip_atomic_load(p, __ATOMIC_RELAXED, __HIP_MEMORY_SCOPE_AGENT); }
__device__ __forceinline__ unsigned xb_add(unsigned* p, unsigned v) { return __hip_atomic_fetch_add(p, v, __ATOMIC_RELAXED, __HIP_MEMORY_SCOPE_AGENT); }
__device__ __forceinline__ unsigned xb_xcc_id() { return (unsigned)__builtin_amdgcn_s_getreg((3 << 11) | 20) & 0xFu; }
#define XB_SPIN(cond, bar) do { unsigned _sp = 0; while (cond) { __builtin_amdgcn_s_sleep(1); \
    if ((++_sp & 255u) == 0u) { if (xb_ld(&(bar)[XB_TMO])) break; if (_sp > XB_SPIN_CAP) { atomicAdd(&(bar)[XB_TMO], 1u); break; } } } } while (0)

struct XcdBarrier {
    unsigned* bar; unsigned x;
    volatile LAS unsigned* st;
};

__device__ __forceinline__ XcdBarrier xcd_barrier_post(unsigned* bar, volatile LAS unsigned* st) {
    XcdBarrier b; b.bar = bar; b.x = xb_xcc_id(); b.st = st;
    if (threadIdx.x == 0) (void)xb_add(&bar[XB_XCNT(b.x)], 1u);
    return b;
}
__device__ __forceinline__ void xcd_barrier_complete(unsigned* bar, unsigned x, unsigned& nloc, unsigned& nx) {
    const unsigned G = gridDim.x * gridDim.y * gridDim.z;
    unsigned sum, cnt, mine, sp = 0u;
    for (;;) {
        sum = 0u; cnt = 0u; mine = 0u;
#pragma unroll
        for (unsigned j = 0; j < 16; ++j) { const unsigned c = xb_ld(&bar[XB_XCNT(j)]); sum += c; cnt += (c > 0u) ? 1u : 0u; mine = (j == x) ? c : mine; }
        if (sum == G) break;
        __builtin_amdgcn_s_sleep(1);
        if ((++sp & 255u) == 0u) { if (xb_ld(&bar[XB_TMO])) break; if (sp > XB_SPIN_CAP) { atomicAdd(&bar[XB_TMO], 1u); break; } }
    }
    nloc = mine > 0u ? mine : 1u; nx = cnt > 0u ? cnt : 1u;
}

__device__ __forceinline__ void xcd_barrier(const XcdBarrier& b) {
    asm volatile("s_waitcnt vmcnt(0)" ::: "memory");
    __syncthreads();
    if (threadIdx.x == 0) {
        unsigned* bar = b.bar;
        __builtin_amdgcn_s_waitcnt(0);
        unsigned nloc = b.st[0], nx = b.st[1];
        if (nloc == 0u) { xcd_barrier_complete(bar, b.x, nloc, nx); b.st[0] = nloc; b.st[1] = nx; }
        const unsigned old = xb_add(&bar[XB_XSUB(b.x)], 1u);
        const unsigned gen = old / nloc;
        if (old + 1u == (gen + 1u) * nloc) {
            __builtin_amdgcn_fence(__ATOMIC_RELEASE, "agent");
            asm volatile("s_waitcnt vmcnt(0)" ::: "memory");
            const unsigned og = xb_add(&bar[XB_TOP], 1u);
            const unsigned tg = og / nx;
            if (og + 1u == (tg + 1u) * nx) xb_add(&bar[XB_TOPGEN], 1u);
            else XB_SPIN(xb_ld(&bar[XB_TOPGEN]) == tg, bar);
            __builtin_amdgcn_fence(__ATOMIC_ACQUIRE, "agent");
            xb_add(&bar[XB_XGEN(b.x)], 1u);
            asm volatile("s_waitcnt vmcnt(0)" ::: "memory");
        } else {
            XB_SPIN(xb_ld(&bar[XB_XGEN(b.x)]) == gen, bar);
            __builtin_amdgcn_fence(__ATOMIC_ACQUIRE, "agent");
            asm volatile("s_waitcnt vmcnt(0)" ::: "memory");
        }
    }
    __syncthreads();
}

#ifndef DBG
#define DBG 0
#endif
__device__ __forceinline__ void dbg_dump(const bf16_t* src, float* out, size_t n, int G, int bid, int tid) {
    for (size_t i = (size_t)bid * NTHREADS + tid; i < n; i += (size_t)G * NTHREADS) out[i] = bf_lo((unsigned)src[i]);
}
#define DBG_AT(k, ...) if constexpr (DBG == (k)) { __VA_ARGS__; return; }
__global__ void __launch_bounds__(NTHREADS, 2) fwd_megakernel(Args a) {
    extern __shared__ __attribute__((aligned(16))) unsigned char lds_raw[];
    LAS unsigned char* lds = (LAS unsigned char*)lds_raw;
    cg::grid_group grid = cg::this_grid();
#ifndef PROBE
#define PROBE -1
#endif
#define REP(k) for (int rep_ = 0; rep_ < ((PROBE == (k)) ? 2 : 1); ++rep_)
    volatile LAS unsigned* misc = (volatile LAS unsigned*)(lds + 131072 + 256);
    if (threadIdx.x < 4) misc[threadIdx.x] = 0u;
    __syncthreads();
    XcdBarrier xbar = xcd_barrier_post((unsigned*)(a.ws + WS_BAR), misc);
#define GRID_SYNC() xcd_barrier(xbar)
    const int tid = threadIdx.x, bid = blockIdx.x, G = gridDim.x;
    unsigned char* ws = a.ws;
    typedef bf16_t* BP; typedef float* FP;

#ifndef PHMASK
#define PHMASK 0xFFFFF
#endif
#define PH(k) if constexpr ((PHMASK >> (k)) & 1)
    REP(0) PH(0) { int t_ = tid; asm volatile("" : "+v"(t_)); p0_prologue(a, lds, G, bid, t_); }
    GRID_SYNC();
    if (G == 0x7fffffff) grid.sync();
    REP(1) {
        PH(1) { Gemm g{(BP)(ws + WS_XB), (BP)(ws + WS_WA), SEQ, 4096, DM, DM, DM, 0}; StaticOrder S; S.init(SEQ, 4096, G, bid);
          EpiIn E{(FP)(ws + WS_RSTD1), (BP)(ws + WS_Q), (BP)(ws + WS_K), (BP)(ws + WS_XR), (BP)(ws + WS_YR), a.in[I_QN], a.in[I_KN], 0.125f * LOG2E};
          gemm_phase<EpiIn, StaticOrder, true, true>(lds, g, S, E); }
        __syncthreads();
        PH(2) { Gemm g{(BP)(ws + WS_WV), (BP)(ws + WS_XB), 1024, SEQ, DM, DM, DM, 0}; StaticOrder S; S.init(1024, SEQ, G, bid);
          EpiVT E{(FP)(ws + WS_RSTD1), (BP)(ws + WS_VT)};
          gemm_phase<EpiVT, StaticOrder, true, true>(lds, g, S, E); }
    }
    GRID_SYNC();
    DBG_AT(1, dbg_dump((BP)(ws + WS_Q), a.out, (size_t)SEQ * 2048, G, bid, tid))
    DBG_AT(2, dbg_dump((BP)(ws + WS_VT), a.out, (size_t)SEQ * 2048, G, bid, tid))
    REP(2) { int t_ = tid; asm volatile("" : "+v"(t_)); rnn_front_phase(a, lds, G, bid, t_); }
    GRID_SYNC();
    DBG_AT(3, dbg_dump((BP)(ws + WS_LA), a.out, (size_t)SEQ * 2048, G, bid, tid))
    REP(5) { PH(9) { int t_ = tid; asm volatile("" : "+v"(t_)); scanC_phase(a, lds, G, bid, t_); }
    PH(10) { int t_ = tid; asm volatile("" : "+v"(t_)); attn_phase(a, lds, G, bid, t_); } }
    GRID_SYNC();
    DBG_AT(5, dbg_dump((BP)(ws + WS_MIX), a.out, (size_t)SEQ * 2048, G, bid, tid))
    DBG_AT(7, for (size_t i = (size_t)bid * NTHREADS + tid; i < (size_t)SEQ * 2048; i += (size_t)G * NTHREADS) a.out[i] = (i & 2047) < 1024 ? bf_lo((unsigned)((BP)(ws + WS_MIX))[i]) : 0.f)
    DBG_AT(8, for (size_t i = (size_t)bid * NTHREADS + tid; i < (size_t)SEQ * 2048; i += (size_t)G * NTHREADS) a.out[i] = (i & 2047) >= 1024 ? bf_lo((unsigned)((BP)(ws + WS_MIX))[i]) : 0.f)
    REP(6) PH(11) { Gemm g{(BP)(ws + WS_MIX), (BP)(ws + WS_WOUT), SEQ, DM, DM, DM, DM, 0}; StaticOrder S; S.init(SEQ, DM, G, bid);
      EpiRes<true, true> E{(const void*)(ws + WS_XB), (void*)(ws + WS_XB), (FP)(ws + WS_SSQP2)};
      gemm_phase<EpiRes<true, true>, StaticOrder, true, true>(lds, g, S, E); }
    GRID_SYNC();
    REP(7) PH(12) { Gemm g{(BP)(ws + WS_XB), (BP)(ws + WS_WXQ), SEQ, XW, DM, DM, DM, 0}; StaticOrder S; S.init(SEQ, XW, G, bid);
      EpiPlain<false> E{(void*)(ws + WS_XQ), XW, (FP)(ws + WS_SSQP2)};
      gemm_phase<EpiPlain<false>, StaticOrder, true, true>(lds, g, S, E); }
    __syncthreads();
    { Gemm g{(BP)(ws + WS_MEMN), (BP)(ws + WS_WXK), MEML, XW, DM, DM, DM, 0}; StaticOrder S; S.init(MEML, XW, G, (bid + 128) % G);
      EpiPlain<true> E{(void*)(ws + WS_MKRAW), XW, nullptr};
      gemm_phase<EpiPlain<true>, StaticOrder, true, true>(lds, g, S, E); }
    __syncthreads();
    { Gemm g{(BP)(ws + WS_WXV), (BP)(ws + WS_MEMN), XW, MEML, DM, DM, DM, 0}; StaticOrder S; S.init(XW, MEML, G, (bid + 126) % G);
      EpiPlain<false> E{(void*)(ws + WS_MVT), MEML, nullptr};
      gemm_phase<EpiPlain<false>, StaticOrder, true, true>(lds, g, S, E); }
    __syncthreads();
    { const int first_idle = (SEQ / 256) * (XW / 256) + 4;
      if (G > first_idle + 16) { if (bid >= first_idle) { int t_ = tid; asm volatile("" : "+v"(t_)); wdn_convert(a, lds, G - first_idle, bid - first_idle, t_); } }
      else { int t_ = tid; asm volatile("" : "+v"(t_)); wdn_convert(a, lds, G, bid, t_); } }
    GRID_SYNC();
    REP(8) PH(13) { int t_ = tid; asm volatile("" : "+v"(t_)); xattn_phase(a, lds, G, bid, t_); }
    GRID_SYNC();
    PH(14) { Gemm g{(BP)(ws + WS_XOIN), (BP)(ws + WS_WXO), SEQ, DM, XW, XW, XW, 0}; StaticOrder S; S.init(SEQ, DM, G, bid);
      EpiRes<true, true> E{(const void*)(ws + WS_XB), (void*)(ws + WS_XB), (FP)(ws + WS_SSQP3)};
      gemm_phase<EpiRes<true, true>, StaticOrder, true, true>(lds, g, S, E); }
    GRID_SYNC();
    REP(10) PH(15) { Gemm g{(BP)(ws + WS_XB), (BP)(ws + WS_WGU), SEQ, 2 * DFF, DM, DM, DM, 0}; StaticOrder S; S.init(SEQ, 2 * DFF, G, bid);
      EpiGU E{(FP)(ws + WS_SSQP3), (BP)(ws + WS_HID)};
      gemm_phase<EpiGU, StaticOrder, true, true>(lds, g, S, E); }
    GRID_SYNC();
    PH(16) { Gemm g{(BP)(ws + WS_HID), (BP)(ws + WS_WDN), SEQ, DM, DFF, DFF, DFF, 0}; StaticOrder S; S.init(SEQ, DM, G, bid);
      EpiRes<true, false> E{(const void*)(ws + WS_XB), (void*)a.out, nullptr};
      gemm_phase<EpiRes<true, false>, StaticOrder, true, true>(lds, g, S, E); }
}

extern "C" void kernel_launch(void* const* d_in, const int* in_sizes, int n_in, void* d_out, int out_size, void* d_ws, size_t ws_size, hipStream_t stream) {
    static int grid = 0;
    if (grid == 0) {
        if (n_in != 32 || ws_size < WS_END) { fprintf(stderr, "kernel_launch: unexpected problem (n_in %d, ws %zu)\n", n_in, ws_size); grid = -1; return; }
        int dev = 0, cus = 0, per_cu = 0;
        hipGetDevice(&dev); hipDeviceGetAttribute(&cus, hipDeviceAttributeMultiprocessorCount, dev);
        if (hipFuncSetAttribute((const void*)fwd_megakernel, hipFuncAttributeMaxDynamicSharedMemorySize, LDS_BYTES) != hipSuccess) { fprintf(stderr, "kernel_launch: hipFuncSetAttribute failed\n"); grid = -1; return; }
        hipOccupancyMaxActiveBlocksPerMultiprocessor(&per_cu, (const void*)fwd_megakernel, NTHREADS, LDS_BYTES);
        if (per_cu < 1) { fprintf(stderr, "kernel_launch: occupancy query says %d blocks per CU\n", per_cu); per_cu = 1; }
        (void)hipGetLastError();
        grid = cus * per_cu;
    }
    if (grid < 0) return;
    if (hipMemsetAsync((char*)d_ws + WS_BAR, 0, 16 * KiB, stream) != hipSuccess) { fprintf(stderr, "kernel_launch: hipMemsetAsync failed\n"); return; }
    Args a{};
    for (int i = 0; i < 32; ++i) a.in[i] = (const float*)d_in[i];
    a.out = (float*)d_out; a.ws = (unsigned char*)d_ws;
    void* args[] = {&a};
    hipError_t e = hipLaunchCooperativeKernel((const void*)fwd_megakernel, dim3(grid), dim3(NTHREADS), args, LDS_BYTES, stream);
    if (e != hipSuccess) fprintf(stderr, "cooperative launch failed: %s (grid %d)\n", hipGetErrorString(e), grid);
}
```
